# Optimizing an MI355X kernel written in HIP

```python
import numpy as np
import jax
import jax.numpy as jnp
from jax import lax

D_MODEL = 1024
BATCH = 4
SEQ = 4096
DEPTH = 2

HEAD_DIM = 64
N_HEADS = D_MODEL // HEAD_DIM
A_HEADS = N_HEADS // 2
B_Q_HEADS = N_HEADS // 2
B_KV_HEADS = max(1, B_Q_HEADS // 4)
C_HEADS = N_HEADS
DIL_CONFIGS = ((128, 1), (512, 4), (2048, 16))
A_BLOCK = 128
B_WINDOW = 128
B_BLOCK = 128
GRID_W = 64
NA_ROWS = 8
NA_COLS = 16
NA_COL_BLOCK = 16
NA_COL_SPAN = 32
D_FF_DENSE = 128 * ((8 * D_MODEL // 3 + 127) // 128)
N_EXPERTS = 8
TOP_K = 2
D_FF_EXPERT = 7 * D_MODEL // 2
RMS_EPS = 1e-6
NEG_INF = -1e30
EVEN_SPLITS = (A_HEADS * HEAD_DIM, A_HEADS * HEAD_DIM, A_HEADS * HEAD_DIM,
               B_Q_HEADS * HEAD_DIM, B_KV_HEADS * HEAD_DIM, B_KV_HEADS * HEAD_DIM)
EVEN_IN = sum(EVEN_SPLITS)
EVEN_OUT = (A_HEADS + B_Q_HEADS) * HEAD_DIM
N_EVEN = (DEPTH + 1) // 2
N_ODD = DEPTH // 2

kernel_name = 'hybrid_dilated_swa_natten_moe_encoder'


def rms_norm(x, g):
    xf = x.astype(jnp.float32)
    y = xf * lax.rsqrt(jnp.mean(xf * xf, axis=-1, keepdims=True) + RMS_EPS)
    return (y * g.astype(jnp.float32)).astype(x.dtype)


def alibi_slopes():
    s = np.exp2(-8.0 * np.arange(1, N_HEADS + 1) / N_HEADS).astype(np.float32)
    return jnp.asarray(s[0::2][:A_HEADS]), jnp.asarray(s[1::2][:B_Q_HEADS])


def to_heads(t, n):
    b, s, _ = t.shape
    return t.reshape(b, s, n, HEAD_DIM).transpose(0, 2, 1, 3)


def banded_attention(q, k, v, radius, block, pos_scale, slopes, sink=None):
    n, hq, seq_len, hd = q.shape
    hkv = k.shape[1]
    g = hq // hkv
    blk = min(block, seq_len)
    nb = -(-seq_len // blk)
    lp = nb * blk
    span = blk + 2 * radius
    qb = jnp.pad(q, ((0, 0), (0, 0), (0, lp - seq_len), (0, 0))).reshape(n, hkv, g, nb, blk, hd)
    pad = ((0, 0), (0, 0), (radius, lp - seq_len + radius), (0, 0))
    idx = np.arange(nb)[:, None] * blk + np.arange(span)[None, :]
    kb = jnp.take(jnp.pad(k, pad), idx.reshape(-1), axis=2).reshape(n, hkv, nb, span, hd)
    vb = jnp.take(jnp.pad(v, pad), idx.reshape(-1), axis=2).reshape(n, hkv, nb, span, hd)
    qpos = np.arange(nb)[:, None] * blk + np.arange(blk)[None, :]
    kpos = idx - radius
    dist = np.abs(qpos[:, :, None] - kpos[:, None, :])
    valid = (dist <= radius) & (kpos[:, None, :] >= 0) & (kpos[:, None, :] < seq_len)
    bias = -slopes.astype(jnp.float32).reshape(hkv, g, 1, 1, 1) * jnp.asarray(dist * pos_scale, jnp.float32)
    s = jnp.einsum('nkgbqd,nkbsd->nkgbqs', qb, kb).astype(jnp.float32) * (hd ** -0.5) + bias
    s = jnp.where(jnp.asarray(valid), s, NEG_INF)
    m = jnp.max(s, axis=-1)
    if sink is not None:
        sk = sink.astype(jnp.float32).reshape(hkv, g, 1, 1)
        m = jnp.maximum(m, sk)
    p = jnp.exp(s - m[..., None])
    l = jnp.sum(p, axis=-1)
    if sink is not None:
        l = l + jnp.exp(sk - m)
    o = jnp.einsum('nkgbqs,nkbsd->nkgbqd', p, vb.astype(jnp.float32)) / l[..., None]
    o = o.reshape(n, hq, lp, hd)[:, :, :seq_len]
    lse = (m + jnp.log(l)).reshape(n, hq, lp)[:, :, :seq_len]
    return o, lse


def dilated_attention(q, k, v, slopes):
    b, h, s, hd = q.shape
    outs, lses = [], []
    for window, r in DIL_CONFIGS:
        seg = s // r

        def fold(t):
            return t.reshape(b, h, seg, r, hd).transpose(0, 3, 1, 2, 4).reshape(b * r, h, seg, hd)

        o, lse = banded_attention(fold(q), fold(k), fold(v), radius=window // (2 * r),
                                  block=A_BLOCK, pos_scale=r, slopes=slopes)
        outs.append(o.reshape(b, r, h, seg, hd).transpose(0, 2, 3, 1, 4).reshape(b, h, s, hd))
        lses.append(lse.reshape(b, r, h, seg).transpose(0, 2, 3, 1).reshape(b, h, s))
    w = jax.nn.softmax(jnp.stack(lses), axis=0)
    return sum(w[i][..., None] * outs[i] for i in range(len(outs)))


def even_mixer(h, w_in, qn_a, kn_a, qn_b, kn_b, sink_b, w_out):
    b, s, _ = h.shape
    proj = h @ w_in
    qa, ka, va, qb, kb, vb = jnp.split(proj, np.cumsum(EVEN_SPLITS)[:-1].tolist(), axis=-1)
    qa = rms_norm(to_heads(qa, A_HEADS), qn_a)
    ka = rms_norm(to_heads(ka, A_HEADS), kn_a)
    va = to_heads(va, A_HEADS)
    qb = rms_norm(to_heads(qb, B_Q_HEADS), qn_b)
    kb = rms_norm(to_heads(kb, B_KV_HEADS), kn_b)
    vb = to_heads(vb, B_KV_HEADS)
    slopes_a, slopes_b = alibi_slopes()
    oa = dilated_attention(qa, ka, va, slopes_a)
    ob, _ = banded_attention(qb, kb, vb, radius=B_WINDOW, block=B_BLOCK, pos_scale=1,
                             slopes=slopes_b, sink=sink_b)
    o = jnp.concatenate([oa, ob], axis=1).transpose(0, 2, 1, 3).reshape(b, s, EVEN_OUT)
    return o.astype(h.dtype) @ w_out


def neighbourhood_mixer(h, w_qkv, qn, kn, rpb, w_out):
    b, s, _ = h.shape
    rows = s // GRID_W
    kh = min(NA_ROWS, rows)
    q, k, v = jnp.split(h @ w_qkv, 3, axis=-1)
    q = rms_norm(to_heads(q, C_HEADS), qn)
    k = rms_norm(to_heads(k, C_HEADS), kn)
    v = to_heads(v, C_HEADS)
    qg = q.reshape(b, C_HEADS, rows, GRID_W, HEAD_DIM)
    kg = k.reshape(b, C_HEADS, rows, GRID_W, HEAD_DIM)
    vg = v.reshape(b, C_HEADS, rows, GRID_W, HEAD_DIM)
    n_cb = GRID_W // NA_COL_BLOCK
    qcol = np.arange(GRID_W).reshape(n_cb, NA_COL_BLOCK)
    kcol = np.clip(qcol[:, 0] - NA_COLS // 2, 0, GRID_W - NA_COL_SPAN)[:, None] + np.arange(NA_COL_SPAN)
    qstart = np.clip(qcol - NA_COLS // 2, 0, GRID_W - NA_COLS)
    col_valid = jnp.asarray((kcol[:, None, :] >= qstart[:, :, None]) &
                            (kcol[:, None, :] < qstart[:, :, None] + NA_COLS))
    col_off = np.clip(kcol[:, None, :] - qcol[:, :, None], -(NA_COLS - 1), NA_COLS - 1) + NA_COLS - 1
    rpb_cols = jnp.take(rpb.astype(jnp.float32), col_off.reshape(-1), axis=2).reshape(
        C_HEADS, 2 * NA_ROWS - 1, n_cb, NA_COL_BLOCK, NA_COL_SPAN)
    kcol_flat = kcol.reshape(-1)

    def row_step(i):
        rs = jnp.clip(i - kh // 2, 0, rows - kh)
        qi = lax.dynamic_index_in_dim(qg, i, axis=2, keepdims=False).reshape(
            b, C_HEADS, n_cb, NA_COL_BLOCK, HEAD_DIM)
        kr = lax.dynamic_slice_in_dim(kg, rs, kh, axis=2)
        vr = lax.dynamic_slice_in_dim(vg, rs, kh, axis=2)
        kc = jnp.take(kr, kcol_flat, axis=3).reshape(b, C_HEADS, kh, n_cb, NA_COL_SPAN, HEAD_DIM)
        vc = jnp.take(vr, kcol_flat, axis=3).reshape(b, C_HEADS, kh, n_cb, NA_COL_SPAN, HEAD_DIM)
        sc = jnp.einsum('bhcqd,bhrckd->bhcqrk', qi, kc).astype(jnp.float32) * (HEAD_DIM ** -0.5)
        row_off = rs + jnp.arange(kh) - i + NA_ROWS - 1
        bias = jnp.take(rpb_cols, row_off, axis=1).transpose(0, 2, 3, 1, 4)
        sc = jnp.where(col_valid[:, :, None, :], sc + bias, NEG_INF)
        p = jax.nn.softmax(sc.reshape(sc.shape[:4] + (kh * NA_COL_SPAN,)), axis=-1).reshape(sc.shape)
        return jnp.einsum('bhcqrk,bhrckd->bhcqd', p, vc.astype(jnp.float32))

    o = lax.map(row_step, jnp.arange(rows))
    o = o.transpose(1, 2, 0, 3, 4, 5).reshape(b, C_HEADS, s, HEAD_DIM)
    o = o.transpose(0, 2, 1, 3).reshape(b, s, C_HEADS * HEAD_DIM)
    return o.astype(h.dtype) @ w_out


def swiglu(h, w_gate, w_up, w_down):
    return (jax.nn.silu(h @ w_gate) * (h @ w_up)) @ w_down


def moe_swiglu(h, w_router, w_gate, w_up, w_down):
    b, s, d = h.shape
    t = h.reshape(b * s, d)
    logits = (t @ w_router).astype(jnp.float32)
    top_v, top_i = lax.top_k(logits, TOP_K)
    gates = jax.nn.softmax(top_v, axis=-1)
    combine = jnp.sum(jax.nn.one_hot(top_i, N_EXPERTS, dtype=jnp.float32) * gates[..., None], axis=1)
    out = jnp.zeros((b * s, d), jnp.float32)
    for e in range(N_EXPERTS):
        y = swiglu(t, w_gate[e], w_up[e], w_down[e]).astype(jnp.float32)
        out = out + combine[:, e:e + 1] * y
    return out.reshape(b, s, d).astype(h.dtype)


def setup_inputs(seed: int = 0) -> dict:
    key = jax.random.key(seed)
    ks = iter(jax.random.split(key, 32))

    def nrm(shape, scale):
        return scale * jax.random.normal(next(ks), shape, jnp.float32)

    def gain(shape):
        return 1.0 + 0.05 * jax.random.normal(next(ks), shape, jnp.float32)

    d = D_MODEL
    return {
        'x': nrm((BATCH, SEQ, d), 1.0),
        'ev_norm1': gain((N_EVEN, d)),
        'ev_w_in': nrm((N_EVEN, d, EVEN_IN), d ** -0.5),
        'ev_qn_a': gain((N_EVEN, HEAD_DIM)),
        'ev_kn_a': gain((N_EVEN, HEAD_DIM)),
        'ev_qn_b': gain((N_EVEN, HEAD_DIM)),
        'ev_kn_b': gain((N_EVEN, HEAD_DIM)),
        'ev_sink_b': nrm((N_EVEN, B_Q_HEADS), 1.0),
        'ev_w_out': nrm((N_EVEN, EVEN_OUT, d), EVEN_OUT ** -0.5),
        'ev_norm2': gain((N_EVEN, d)),
        'ev_ffn_gate': nrm((N_EVEN, d, D_FF_DENSE), d ** -0.5),
        'ev_ffn_up': nrm((N_EVEN, d, D_FF_DENSE), d ** -0.5),
        'ev_ffn_down': nrm((N_EVEN, D_FF_DENSE, d), D_FF_DENSE ** -0.5),
        'od_norm1': gain((N_ODD, d)),
        'od_w_qkv': nrm((N_ODD, d, 3 * C_HEADS * HEAD_DIM), d ** -0.5),
        'od_qn': gain((N_ODD, HEAD_DIM)),
        'od_kn': gain((N_ODD, HEAD_DIM)),
        'od_rpb': nrm((N_ODD, C_HEADS, 2 * NA_ROWS - 1, 2 * NA_COLS - 1), 0.5),
        'od_w_out': nrm((N_ODD, C_HEADS * HEAD_DIM, d), (C_HEADS * HEAD_DIM) ** -0.5),
        'od_norm2': gain((N_ODD, d)),
        'od_router': nrm((N_ODD, d, N_EXPERTS), d ** -0.5),
        'od_exp_gate': nrm((N_ODD, N_EXPERTS, d, D_FF_EXPERT), d ** -0.5),
        'od_exp_up': nrm((N_ODD, N_EXPERTS, d, D_FF_EXPERT), d ** -0.5),
        'od_exp_down': nrm((N_ODD, N_EXPERTS, D_FF_EXPERT, d), D_FF_EXPERT ** -0.5),
    }


def reference(x, ev_norm1, ev_w_in, ev_qn_a, ev_kn_a, ev_qn_b, ev_kn_b, ev_sink_b, ev_w_out,
              ev_norm2, ev_ffn_gate, ev_ffn_up, ev_ffn_down,
              od_norm1, od_w_qkv, od_qn, od_kn, od_rpb, od_w_out, od_norm2, od_router,
              od_exp_gate, od_exp_up, od_exp_down):
    for layer in range(DEPTH):
        j = layer // 2
        if layer % 2 == 0:
            h = rms_norm(x, ev_norm1[j])
            x = x + even_mixer(h, ev_w_in[j], ev_qn_a[j], ev_kn_a[j], ev_qn_b[j], ev_kn_b[j],
                               ev_sink_b[j], ev_w_out[j])
            h = rms_norm(x, ev_norm2[j])
            x = x + swiglu(h, ev_ffn_gate[j], ev_ffn_up[j], ev_ffn_down[j])
        else:
            h = rms_norm(x, od_norm1[j])
            x = x + neighbourhood_mixer(h, od_w_qkv[j], od_qn[j], od_kn[j], od_rpb[j], od_w_out[j])
            h = rms_norm(x, od_norm2[j])
            x = x + moe_swiglu(h, od_router[j], od_exp_gate[j], od_exp_up[j], od_exp_down[j])
    return x
```

```cpp
#include <hip/hip_runtime.h>
#include <cstdio>
#include <cstdint>
#include <cmath>

#define LAS __attribute__((address_space(3)))
#define GAS __attribute__((address_space(1)))
typedef unsigned short bf16_t;
typedef short bf16x8 __attribute__((ext_vector_type(8)));
typedef short s16x4 __attribute__((ext_vector_type(4)));
typedef float f32x4 __attribute__((ext_vector_type(4)));
typedef float f32x2 __attribute__((ext_vector_type(2)));
typedef float f32x16 __attribute__((ext_vector_type(16)));
typedef unsigned u32x4 __attribute__((ext_vector_type(4)));
typedef unsigned u32x2 __attribute__((ext_vector_type(2)));
typedef GAS unsigned gu32;
#define RLX_AGENT __ATOMIC_RELAXED, __HIP_MEMORY_SCOPE_AGENT
#define LDS_WAIT() asm volatile("s_waitcnt lgkmcnt(0)" ::: "memory")
#define VM_WAIT() asm volatile("s_waitcnt vmcnt(0)" ::: "memory")

constexpr int D = 1024, SEQ = 4096, NB = 4, M = NB * SEQ, HD = 64;
constexpr int N_IN0 = 2304, FF0 = 2816, N_QKV1 = 3072, NE = 8, FFE = 3584;
constexpr float EPS = 1e-6f, LOG2E = 1.4426950408889634f, C2 = 0.125f * LOG2E;
constexpr float W8_SCALE = 32.f, X8_SCALE = 16.f, H8_SCALE = 4.f;
constexpr int CAP = 16384;
constexpr int MAXT = 136;

constexpr size_t MiB = 1u << 20;
constexpr size_t WS_CTL = 0, CTL_ZERO_BYTES = 32 * 1024;
constexpr size_t WS_ROWTOK = 1 * MiB;
constexpr size_t WS_ROWGATE = 2 * MiB;
constexpr size_t WS_ROWRS = 2 * MiB + 512 * 1024;
constexpr size_t WS_SS = 3 * MiB;
constexpr size_t WS_XB = 4 * MiB;
constexpr size_t WS_WGUE = 36 * MiB;
constexpr size_t WS_XB8 = 92 * MiB;
constexpr size_t WS_Y2 = 36 * MiB;
constexpr size_t WS_Y1 = 68 * MiB;
constexpr size_t WS_WDE = 148 * MiB;
constexpr size_t WS_BIG = 204 * MiB;
constexpr size_t WS_HM = WS_BIG;
constexpr size_t WS_QKV = WS_BIG;
constexpr size_t WS_H0 = WS_BIG;
constexpr size_t WS_AO = WS_BIG + 96 * MiB;
constexpr size_t WS_WIN = WS_BIG + 128 * MiB;
constexpr size_t WS_WOUT0 = WS_WIN + 4608 * 1024;
constexpr size_t WS_WGU0 = WS_WOUT0 + 2 * MiB;
constexpr size_t WS_WD0 = WS_WGU0 + 11 * MiB;
constexpr size_t WS_WQKV1 = WS_WD0 + 5632 * 1024;
constexpr size_t WS_WOUT1 = WS_WQKV1 + 6 * MiB;
constexpr size_t WS_PA1 = WS_WOUT1 + 2 * MiB;
constexpr size_t WS_PA4 = WS_PA1 + 16 * MiB;
constexpr size_t WS_LSE = WS_PA4 + 16 * MiB;
constexpr size_t WS_Y2X = WS_BIG + 238 * MiB;
constexpr size_t WS_END = WS_Y2X + 9 * 256 * 2048;
static_assert(WS_LSE + 2 * (size_t)M * 8 * 4 <= WS_END, "d_ws map");
static_assert((size_t)MAXT * 256 * FFE * 2 <= 238 * MiB, "HM fits");
constexpr int CW_CNT = 64;
constexpr int CW_CA = 1024;
constexpr int CW_BAR = 4096;

constexpr int RING_BYTES = 147456;
constexpr int EPI_OFF = 131072;
constexpr int RPB_OFF = 147456;
constexpr int MISC_OFF = 151552;
constexpr int ULIST_OFF = MISC_OFF + 256;
constexpr int OSTAGE_OFF = ULIST_OFF + 512;
constexpr int RS_OFF = OSTAGE_OFF + 8192;
constexpr int GN_OFF = RS_OFF + 2048;
constexpr int LDS_BYTES = GN_OFF + 1024;

__device__ __forceinline__ unsigned f2bf(float f) { unsigned u = __builtin_bit_cast(unsigned, f); return (u + 0x7fffu + ((u >> 16) & 1u)) >> 16; }
__device__ __forceinline__ unsigned pk2(float lo, float hi) { return f2bf(lo) | (f2bf(hi) << 16); }
__device__ __forceinline__ unsigned cvt_pk_bf16(float lo, float hi) { unsigned r; asm volatile("v_cvt_pk_bf16_f32 %0, %1, %2" : "=v"(r) : "v"(lo), "v"(hi)); return r; }
__device__ __forceinline__ float bf_lo(unsigned w) { return __builtin_bit_cast(float, w << 16); }
__device__ __forceinline__ float bf_hi(unsigned w) { return __builtin_bit_cast(float, w & 0xffff0000u); }
__device__ __forceinline__ float wave_sum(float v) {
#pragma unroll
    for (int o = 1; o < 64; o <<= 1) v += __shfl_xor(v, o);
    return v;
}
__device__ __forceinline__ float xor16_sum(float v) { float a = v, b = v; asm volatile("s_nop 1\n\tv_permlane16_swap_b32 %0, %1\n\ts_nop 1" : "+v"(a), "+v"(b)); return a + b; }
__device__ __forceinline__ float xor32_sum(float v) { float a = v, b = v; asm volatile("s_nop 1\n\tv_permlane32_swap_b32 %0, %1\n\ts_nop 1" : "+v"(a), "+v"(b)); return a + b; }
__device__ __forceinline__ float rstd_of(const float* ss, int row) { const f32x4 v = *(const f32x4*)(ss + (size_t)row * 4); return rsqrtf(((v.x + v.y) + (v.z + v.w)) * (1.0f / D) + EPS); }
namespace pg8 {
constexpr int BM = 256, BK = 64, HALF = 128, HTB = HALF * BK * 2  , STAGE_BYTES = 8 * HTB, NXCD = 8, WGM = 8;
__host__ __device__ __forceinline__ int lds_byte(int r, int c) { const int st = (r >> 4) * 2 + (c >> 5), rr = r & 15, cc = c & 31, ob = rr * 64 + cc * 2; return st * 1024 + (ob ^ (((ob >> 9) & 1) << 5)); }
__host__ __device__ __forceinline__ void stage_rc(int b, int& R, int& C) { const int st = b / 1024, sb = b % 1024, swz = sb ^ (((sb >> 9) & 1) << 5); R = (st >> 1) * 16 + swz / 64; C = (st & 1) * 32 + (swz % 64) / 2; }
__host__ __device__ __forceinline__ int gray4(int g) { return g ^ (g >> 1); }
__host__ __device__ __forceinline__ int lds_byte8(int r, int c) { const int st = (r >> 4) * 2 + (c >> 5), rr = r & 15, ch = (c >> 3) & 3; return st * 1024 + rr * 64 + ((ch ^ gray4(rr >> 2)) << 4); }
__host__ __device__ __forceinline__ void stage_rc8(int b, int& R, int& C) { const int st = b / 1024, sb = b % 1024, rr = sb / 64, ch = ((sb % 64) / 16) ^ gray4(rr >> 2); R = (st >> 1) * 16 + rr; C = (st & 1) * 32 + ch * 8; }
__host__ __device__ __forceinline__ int perm32(int rho) { const int n = rho >> 4, i = rho & 15; return 8 * (i >> 2) + 4 * n + (i & 3); }

struct Unit { int pm, pn, e, lt, aux, li; };
struct Gemm { const bf16_t* A; const bf16_t* Bt; int K; };

__device__ __forceinline__ void map_unit(int L, int nM, int nN, int nwg, int& pm, int& pn) {
    int wgid = L; { const int q = nwg / NXCD, r = nwg % NXCD, xcd = wgid % NXCD, off = wgid / NXCD; wgid = (xcd < r ? xcd * (q + 1) : r * (q + 1) + (xcd - r) * q) + off; }
    const int nig = WGM * nN, gid = wgid / nig, fm = gid * WGM, gsz = (nM - fm) < WGM ? (nM - fm) : WGM;
    pm = fm + ((wgid % nig) % gsz); pn = (wgid % nig) / gsz;
}
struct DenseOrder {
    int nM, nN, nwg, G, c, K;
    __device__ __forceinline__ void init(int M_, int N_, int K_, int G_, int c_) { nM = M_ / BM; nN = N_ / BM; nwg = nM * nN; G = G_; c = c_; K = K_; }
    __device__ __forceinline__ bool next(int i, Unit& u) const { const long L = (long)i * G + c; if (L >= nwg) return false; map_unit((int)L, nM, nN, nwg, u.pm, u.pn); u.e = 0; u.lt = 0; u.aux = -1; u.li = i; return true; }
    __device__ __forceinline__ unsigned arow(const Unit& u, int r) const { return (unsigned)(u.pm * BM + r); }
    __device__ __forceinline__ size_t boff(const Unit& u) const { return (size_t)u.pn * BM * K * 2; }
};
template <int KIND>
__device__ __forceinline__ void moe_build_list(volatile LAS unsigned* UL, const volatile LAS int* T, int nN, int G, int c, int fast, int tid, const unsigned* rowtok, LAS unsigned* TOKL) {
    if (tid < 64) {
        const int i = tid; int e = 0, lt = 0, pn = 0, aux = -1; bool ok = true;
        const bool all = (KIND == 2 || KIND == 4) && !fast;
        if (all) { const int NT = T[16]; const long L = (long)i * G + c; const int nwg = NT * nN; ok = L < nwg;
            if (ok) { int vt; map_unit((int)L, NT, nN, nwg, vt, pn); int ee = 0; for (int k = 1; k < 8; ++k) ee += (vt >= T[8 + k]) ? 1 : 0; e = ee; lt = vt - T[8 + ee]; } }
        else if (KIND == 3) { ok = i == 0; const int w = T[28 + (c >> 2)]; e = w >> 8; lt = w & 255; pn = c & 3; aux = c >> 2; }
        else {
            long q; const int X = T[17], R = T[27]; int ncol = nN;
            if (KIND == 4) { q = (long)i * G + c; }
            else {
                long L;
                if (KIND == 1) { ok = i == 0; L = c; }
                else { const int NO = 4 * X; const int s = (c < NO) ? i + 5 : i + 1; L = (s <= 4) ? (long)G + (long)(s - 1) * (G - NO) + (c - NO) : (long)G + 4L * (G - NO) + (long)(s - 5) * G + c; }
                const int nx = ncol * X;
                if (L < nx) { const int k = (int)L / ncol; const int w = T[28 + k]; e = w >> 8; lt = w & 255; pn = (int)L % ncol; aux = k; q = -1; }
                else q = L - nx;
            }
            if (q >= 0) { const int nwg = ncol * R; ok = ok && q < nwg;
                if (ok) { int r; map_unit((int)q, R, ncol, nwg, r, pn); int ee = 0; for (int k = 1; k < 8; ++k) ee += (r >= T[19 + k]) ? 1 : 0; e = ee; lt = r - T[19 + ee]; } }
        }
        const int pm = T[8 + e] + lt;
        UL[2 * i] = (unsigned)pm | ((unsigned)pn << 16);
        UL[2 * i + 1] = (unsigned)e | ((unsigned)lt << 8) | ((unsigned)(aux + 1) << 16) | (ok ? 0x80000000u : 0u);
    }
    __syncthreads();
    if (rowtok) {
        for (int idx = tid; idx < 16 * BM; idx += 512) { const int i = idx >> 8, r = idx & 255; const unsigned w1 = UL[2 * i + 1]; unsigned tok = 0u;
            if (w1 >> 31) { const int e = (int)(w1 & 255u), p = (int)((w1 >> 8) & 255u) * BM + r; if (p < T[e]) tok = rowtok[(size_t)e * CAP + p] & 0x7fffffffu; }
            TOKL[idx] = tok; }
        __syncthreads();
    }
}
struct ListOrder {
    int K, Nexp, gather; const volatile LAS unsigned* UL; const volatile LAS int* T; const unsigned* rowtok; const LAS unsigned* TOKL;
    __device__ __forceinline__ void init(const volatile LAS unsigned* UL_, const volatile LAS int* T_, int N_, int K_, int gather_, const unsigned* rowtok_, const LAS unsigned* TOKL_) { UL = UL_; T = T_; K = K_; Nexp = N_; gather = gather_; rowtok = rowtok_; TOKL = TOKL_; }
    __device__ __forceinline__ bool next(int i, Unit& u) const {
        const int ii = i < 63 ? i : 63; const unsigned w0 = UL[2 * ii], w1 = UL[2 * ii + 1];
        u.pm = (int)(w0 & 0xffffu); u.pn = (int)(w0 >> 16); u.e = (int)(w1 & 255u); u.lt = (int)((w1 >> 8) & 255u); u.aux = (int)((w1 >> 16) & 255u) - 1; u.li = i;
        return i < 64 && (w1 >> 31) != 0u; }
    __device__ __forceinline__ unsigned arow(const Unit& u, int r) const {
        if (!gather) return (unsigned)(u.pm * BM + r);
        if (u.li < 16) return TOKL[u.li * BM + r];
        const int idx = u.lt * BM + r; const int cnt = T[u.e];
        return idx < cnt ? (rowtok[(size_t)u.e * CAP + idx] & 0x7fffffffu) : 0u; }
    __device__ __forceinline__ size_t boff(const Unit& u) const { return ((size_t)u.e * Nexp + (size_t)u.pn * BM) * K * 2; }
};

typedef int i32x8 __attribute__((ext_vector_type(8)));
typedef int i32x4 __attribute__((ext_vector_type(4)));
#define pg8_cat(lo, hi) __builtin_shufflevector(lo, hi, 0, 1, 2, 3, 4, 5, 6, 7)
typedef f32x16 AccT[2][2][2];
#define PG8_AG(A_, ai, bj, m, n) ((f32x4){A_[ai][bj][(m) >> 1][(((m) & 1) * 2 + (n)) * 4 + 0], A_[ai][bj][(m) >> 1][(((m) & 1) * 2 + (n)) * 4 + 1], A_[ai][bj][(m) >> 1][(((m) & 1) * 2 + (n)) * 4 + 2], A_[ai][bj][(m) >> 1][(((m) & 1) * 2 + (n)) * 4 + 3]})
#define PG8_AS(A_, ai, bj, m, n, v_) do { A_[ai][bj][(m) >> 1][(((m) & 1) * 2 + (n)) * 4 + 0] = (v_)[0]; A_[ai][bj][(m) >> 1][(((m) & 1) * 2 + (n)) * 4 + 1] = (v_)[1]; A_[ai][bj][(m) >> 1][(((m) & 1) * 2 + (n)) * 4 + 2] = (v_)[2]; A_[ai][bj][(m) >> 1][(((m) & 1) * 2 + (n)) * 4 + 3] = (v_)[3]; } while (0)
template <class Epi, class Sched>
__device__ __forceinline__ void gemm_phase(LAS unsigned char* lds, const Gemm g, const Sched& S, const Epi& E) {
    int tid_ = threadIdx.x; asm volatile("" : "+v"(tid_));
    const int tid = tid_, wid = __builtin_amdgcn_readfirstlane(tid >> 6), lane = tid & 63, wr = wid >> 2, wc = wid & 3, fr = lane & 15, fq = lane >> 4;
    const int K = g.K, nt = K / BK;
    unsigned voffB0; unsigned ca0;
    { int R, C; if (Epi::FP8) stage_rc8(tid * 16, R, C); else stage_rc(tid * 16, R, C);
      const int Rb = Epi::BMODE == 0 ? R : (Epi::BMODE == 1 ? ((R & ~31) + perm32(R & 31)) : (64 * (R >> 5) + perm32(R & 31)));
      voffB0 = (unsigned)(Rb * K + C) * 2u; ca0 = (unsigned)C * 2u; }
    const unsigned dB1 = (unsigned)((Epi::BMODE == 2 ? 128 : 64) * K) * 2u;
    const size_t kstep = (size_t)(BK * 2);
    const size_t hstepB = (size_t)(Epi::BMODE == 2 ? 32 : HALF) * K * 2;
    const unsigned rowb = (unsigned)K * 2u;
    const unsigned ldsw = (unsigned)wid * 1024u;
    const int aoff = Epi::FP8 ? lds_byte8(wr * 64 + fr, fq * 16) : lds_byte(wr * 64 + fr, fq * 8), boff = Epi::FP8 ? lds_byte8(wc * 32 + fr, fq * 16) : lds_byte(wc * 32 + fr, fq * 8);
    const char* const Ab = (const char*)g.A;
#define PG8_SA(b, h) (((b) * 2 + (h)) * HTB)
#define PG8_SB(b, h) ((4 + (b) * 2 + (h)) * HTB)
#define PG8_STG(bufoff, p0, p1, aux) do { \
        __builtin_amdgcn_global_load_lds((const unsigned*)(p0), (LAS unsigned*)(lds + (bufoff) + ldsw), 16, 0, aux); \
        __builtin_amdgcn_global_load_lds((const unsigned*)(p1), (LAS unsigned*)(lds + (bufoff) + ldsw + 8192), 16, 0, aux); } while (0)
#define PG8_STAGEB(bufoff, gbase) PG8_STG(bufoff, (const char*)(gbase) + voffB0, (const char*)(gbase) + voffB0 + dB1, 0)
#define PG8_STAGEA(bufoff, kb, rp) PG8_STG(bufoff, Ab + (kb) + (((rp) & 0xffffu) * rowb + ca0), Ab + (kb) + (((rp) >> 16) * rowb + ca0), Epi::A_AUX)
#define PG8_LDA(dst, b, h) do { if constexpr (Epi::FP8) { _Pragma("unroll") for (int m = 0; m < 4; ++m) dst##8[m] = pg8_cat(*(const LAS i32x4*)(lds + PG8_SA(b, h) + aoff + m * 2048), *(const LAS i32x4*)(lds + PG8_SA(b, h) + (aoff ^ 16) + m * 2048)); } \
        else { _Pragma("unroll") for (int m = 0; m < 4; ++m) _Pragma("unroll") for (int k = 0; k < 2; ++k) dst[m][k] = *(const LAS i32x4*)(lds + PG8_SA(b, h) + aoff + m * 2048 + k * 1024); } } while (0)
#define PG8_LDB(dst, b, h) do { if constexpr (Epi::FP8) { _Pragma("unroll") for (int n = 0; n < 2; ++n) dst##8[n] = pg8_cat(*(const LAS i32x4*)(lds + PG8_SB(b, h) + boff + n * 2048), *(const LAS i32x4*)(lds + PG8_SB(b, h) + (boff ^ 16) + n * 2048)); } \
        else { _Pragma("unroll") for (int n = 0; n < 2; ++n) _Pragma("unroll") for (int k = 0; k < 2; ++k) dst[n][k] = *(const LAS i32x4*)(lds + PG8_SB(b, h) + boff + n * 2048 + k * 1024); } } while (0)
#define PG8_MMA(ai, bj, At, Bt) do { __builtin_amdgcn_s_setprio(1); \
        if constexpr (Epi::FP8) { _Pragma("unroll") for (int m = 0; m < 4; ++m) _Pragma("unroll") for (int n = 0; n < 2; ++n) \
            { const f32x4 r_ = __builtin_amdgcn_mfma_scale_f32_16x16x128_f8f6f4(Bt##8[n], At##8[m], PG8_AG(acc, ai, bj, m, n), 0, 0, 0, 127, 0, 127); PG8_AS(acc, ai, bj, m, n, r_); } } \
        else { _Pragma("unroll") for (int m = 0; m < 4; ++m) _Pragma("unroll") for (int n = 0; n < 2; ++n) _Pragma("unroll") for (int k = 0; k < 2; ++k) \
            { const f32x4 r_ = __builtin_amdgcn_mfma_f32_16x16x32_bf16(__builtin_bit_cast(bf16x8, Bt[n][k]), __builtin_bit_cast(bf16x8, At[m][k]), PG8_AG(acc, ai, bj, m, n), 0, 0, 0); PG8_AS(acc, ai, bj, m, n, r_); } } \
        __builtin_amdgcn_s_setprio(0); } while (0)
#define PG8_WAIT_V(n) asm volatile("s_waitcnt vmcnt(" #n ")" ::: "memory")
#define PG8_WAIT_L(n) asm volatile("s_waitcnt lgkmcnt(" #n ")" ::: "memory")
#define PG8_BAR __builtin_amdgcn_s_barrier()
#define PG8_SCHED __builtin_amdgcn_sched_barrier(0)
#define PG8_ROWS(dst, u) do { int t2_ = tid; asm volatile("" : "+v"(t2_)); int R_, C_; if (Epi::FP8) stage_rc8(t2_ * 16, R_, C_); else stage_rc(t2_ * 16, R_, C_); \
        _Pragma("unroll") for (int h = 0; h < 2; ++h) dst[h] = S.arow(u, h * HALF + R_) | (S.arow(u, h * HALF + R_ + 64) << 16); } while (0)
    Unit cur, nxt; int ui = 0;
    if (!S.next(0, cur)) return;
    AccT acc;
#pragma unroll
    for (int a = 0; a < 2; ++a)
#pragma unroll
        for (int b = 0; b < 2; ++b)
#pragma unroll
            for (int m = 0; m < 2; ++m)
#pragma unroll
                for (int q = 0; q < 16; ++q) acc[a][b][m][q] = 0.f;
    i32x4 At[4][2], B0[2][2], B1[2][2]; i32x8 At8[4], B08[2], B18[2];
    unsigned rc[2], rn[2];
    PG8_ROWS(rc, cur);
    E.pre_store(E.pre_load(cur, tid), 0, lds, tid);
    const char* cB = (const char*)g.Bt + S.boff(cur);
    PG8_STAGEB(PG8_SB(0, 0), cB); PG8_STAGEB(PG8_SB(0, 1), cB + hstepB); PG8_STAGEA(PG8_SA(0, 0), 0, rc[0]); PG8_STAGEA(PG8_SA(0, 1), 0, rc[1]);
    if (wr == 1) PG8_BAR;
    PG8_WAIT_V(2); PG8_BAR;
    PG8_STAGEB(PG8_SB(1, 0), cB + kstep); PG8_STAGEA(PG8_SA(1, 0), kstep, rc[0]); PG8_STAGEB(PG8_SB(1, 1), cB + hstepB + kstep);
    PG8_WAIT_V(6); PG8_BAR;
    for (;;) {
        const bool has_next = S.next(ui + 1, nxt);
        if (has_next) { PG8_ROWS(rn, nxt); } else { rn[0] = rc[0]; rn[1] = rc[1]; }
        const char* nB = has_next ? (const char*)g.Bt + S.boff(nxt) : cB;
#pragma unroll 1
        for (int t = 0; t < nt; t += 2) {
            const bool last = (t == nt - 2);
            const size_t k1 = (size_t)(t + 1) * kstep;
            const size_t k2 = last ? (size_t)0 : (size_t)(t + 2) * kstep, k3 = k2 + kstep;
            const char* b2 = last ? nB : cB + (size_t)(t + 2) * kstep; const char* b3 = b2 + kstep;
            const unsigned ra0 = last ? rn[0] : rc[0], ra1 = last ? rn[1] : rc[1];
            PG8_LDB(B0, 0, 0); PG8_LDB(B1, 0, 1); PG8_SCHED; PG8_LDA(At, 0, 0); PG8_STAGEA(PG8_SA(1, 1), k1, rc[1]);
            PG8_WAIT_V(8); PG8_WAIT_L(0); PG8_BAR; PG8_MMA(0, 0, At, B0); PG8_MMA(0, 1, At, B1); PG8_BAR; PG8_SCHED;
            PG8_LDA(At, 0, 1); PG8_STAGEB(PG8_SB(0, 0), b2); PG8_STAGEB(PG8_SB(0, 1), b2 + hstepB); PG8_STAGEA(PG8_SA(0, 0), k2, ra0);
            PG8_WAIT_V(8); PG8_WAIT_L(0); PG8_BAR; PG8_MMA(1, 0, At, B0); PG8_MMA(1, 1, At, B1); PG8_BAR; PG8_SCHED;
            PG8_LDB(B0, 1, 0); PG8_LDB(B1, 1, 1); PG8_SCHED; PG8_LDA(At, 1, 0); PG8_STAGEA(PG8_SA(0, 1), k2, ra1);
            PG8_WAIT_V(8); PG8_WAIT_L(0); PG8_BAR; PG8_MMA(0, 0, At, B0); PG8_MMA(0, 1, At, B1); PG8_BAR; PG8_SCHED;
            PG8_LDA(At, 1, 1); PG8_STAGEB(PG8_SB(1, 0), b3); PG8_STAGEB(PG8_SB(1, 1), b3 + hstepB); PG8_STAGEA(PG8_SA(1, 0), k3, ra0);
            PG8_WAIT_V(8); PG8_WAIT_L(0); PG8_BAR; PG8_MMA(1, 0, At, B0); PG8_MMA(1, 1, At, B1); PG8_BAR; PG8_SCHED;
        }
        if (Epi::ALIGN) { if (wr == 0) PG8_BAR; }
        const float nrs = has_next ? E.pre_load(nxt, tid) : 0.f;
        E(acc, cur, wr, wc, fr, fq, lds, tid, ui & 1);
        if (!has_next) break;
        E.pre_store(nrs, (ui + 1) & 1, lds, tid);
#pragma unroll
        for (int a = 0; a < 2; ++a)
#pragma unroll
            for (int b = 0; b < 2; ++b)
#pragma unroll
                for (int m = 0; m < 2; ++m)
#pragma unroll
                    for (int q = 0; q < 16; ++q) acc[a][b][m][q] = 0.f;
        cur = nxt; cB = nB; ++ui;
        rc[0] = rn[0]; rc[1] = rn[1];
        if (Epi::ALIGN) { if (wr == 1) PG8_BAR; }
    }
    PG8_WAIT_V(0);
    if (!Epi::ALIGN) { if (wr == 0) PG8_BAR; }
    PG8_BAR;
#undef PG8_SA
#undef PG8_SB
#undef PG8_STG
#undef PG8_STAGEA
#undef PG8_STAGEB
#undef PG8_LDA
#undef PG8_LDB
#undef PG8_MMA
#undef PG8_WAIT_V
#undef PG8_WAIT_L
#undef PG8_BAR
#undef PG8_SCHED
#undef PG8_ROWS
}
}
namespace pg8 {
struct EpiQKV {
    static constexpr int BMODE = 2, A_AUX = 0; static constexpr bool ALIGN = true, FP8 = false; static constexpr int NST = 16;
    bf16_t* O; int ldc; const float* ss; int layer;
    __device__ __forceinline__ float pre_load(const Unit& u, int tid) const { return tid < 256 ? rstd_of(ss, u.pm * BM + tid) : 0.f; }
    __device__ __forceinline__ void pre_store(float v, int buf, LAS unsigned char* lds, int tid) const { if (tid < 256) ((LAS float*)(lds + RS_OFF))[buf * 256 + tid] = v; }
    __device__ __forceinline__ void operator()(const AccT& acc, const Unit& u, int wr, int wc, int fr, int fq, LAS unsigned char* lds, int, int buf) const {
        int kind = 0, gi = 0;
        if (layer == 0) {
            if (u.pn < 2) { kind = 1; gi = 0; } else if (u.pn < 4) { kind = 2; gi = 1; } else if (u.pn < 6) { kind = 0; }
            else if (u.pn < 8) { kind = 1; gi = 2; } else { if (wc < 2) { kind = 2; gi = 3; } }
        } else { if (u.pn < 4) { kind = 1; gi = 0; } else if (u.pn < 8) { kind = 2; gi = 1; } }
        const LAS float* g = (const LAS float*)(lds + GN_OFF) + gi * 64; const LAS float* RS = (const LAS float*)(lds + RS_OFF) + buf * 256;
        f32x4 gv[2][2];
#pragma unroll
        for (int bj = 0; bj < 2; ++bj)
#pragma unroll
            for (int n = 0; n < 2; ++n) gv[bj][n] = kind ? *(const LAS f32x4*)(g + 32 * bj + 8 * fq + 4 * n) : (f32x4){1.f, 1.f, 1.f, 1.f};
        const float post = kind == 1 ? C2 : 1.f;
        bf16_t* slotp = O + (size_t)(4 * u.pn + wc) * M * 64 + 8 * fq;
        float rsv[2][4];
#pragma unroll
        for (int ai = 0; ai < 2; ++ai)
#pragma unroll
            for (int m = 0; m < 4; ++m) rsv[ai][m] = RS[ai * HALF + wr * 64 + m * 16 + fr];
#pragma unroll
        for (int ai = 0; ai < 2; ++ai)
#pragma unroll
            for (int m = 0; m < 4; ++m) {
                const int row = u.pm * BM + ai * HALF + wr * 64 + m * 16 + fr;
                const float rs = rsv[ai][m];
                float sc = rs;
                if (kind) {
                    float q = 0.f;
#pragma unroll
                    for (int bj = 0; bj < 2; ++bj)
#pragma unroll
                        for (int n = 0; n < 2; ++n) { const f32x4 x = PG8_AG(acc, ai, bj, m, n); q += (x[0] * x[0] + x[1] * x[1]) + (x[2] * x[2] + x[3] * x[3]); }
                    q = xor32_sum(xor16_sum(q));
                    sc = rs * __builtin_amdgcn_rsqf(rs * rs * q * (1.0f / 64.0f) + EPS) * post;
                }
                bf16_t* rowp = slotp + (size_t)row * 64;
#pragma unroll
                for (int bj = 0; bj < 2; ++bj) { const f32x4 v0 = PG8_AG(acc, ai, bj, m, 0) * sc * gv[bj][0], v1 = PG8_AG(acc, ai, bj, m, 1) * sc * gv[bj][1];
                    u32x4 w; w.x = cvt_pk_bf16(v0[0], v0[1]); w.y = cvt_pk_bf16(v0[2], v0[3]); w.z = cvt_pk_bf16(v1[0], v1[1]); w.w = cvt_pk_bf16(v1[2], v1[3]);
                    *(u32x4*)(rowp + 32 * bj) = w; }
            }
    }
};
template <bool F8>
struct EpiSwi {
    static constexpr int BMODE = 1, A_AUX = 0; static constexpr bool ALIGN = true, FP8 = F8; static constexpr int NST = 8;
    bf16_t* H; int ldh; const float* ss; const float* rowrs; const volatile LAS int* T;
    __device__ __forceinline__ float pre_load(const Unit& u, int tid) const {
        if (tid >= 256) return 0.f;
        if (rowrs) { const int idx = u.lt * BM + tid; return idx < T[u.e] ? rowrs[(size_t)u.e * CAP + idx] : 0.f; }
        return rstd_of(ss, u.pm * BM + tid); }
    __device__ __forceinline__ void pre_store(float v, int buf, LAS unsigned char* lds, int tid) const { if (tid < 256) ((LAS float*)(lds + RS_OFF))[buf * 256 + tid] = v; }
    __device__ __forceinline__ void operator()(const AccT& acc, const Unit& u, int wr, int wc, int fr, int fq, LAS unsigned char* lds, int, int buf) const {
        const int col0 = u.pn * HALF + 32 * wc + 8 * fq;
        const LAS float* RS = (const LAS float*)(lds + RS_OFF) + buf * 256;
        float rsv[2][4];
#pragma unroll
        for (int ai = 0; ai < 2; ++ai)
#pragma unroll
            for (int m = 0; m < 4; ++m) rsv[ai][m] = RS[ai * HALF + wr * 64 + m * 16 + fr];
#pragma unroll
        for (int ai = 0; ai < 2; ++ai)
#pragma unroll
            for (int m = 0; m < 4; ++m) {
                const int r = ai * HALF + wr * 64 + m * 16 + fr; const int row = u.pm * BM + r;
                const float rs = F8 ? rsv[ai][m] * (1.0f / (W8_SCALE * X8_SCALE)) : rsv[ai][m];
                const float tn = -rs * LOG2E, ic = __builtin_amdgcn_rcpf(rs * rs * (F8 ? H8_SCALE : 1.0f));
                const f32x2 tn2 = {tn, tn}, ic2 = {ic, ic};
                float h[8];
#pragma unroll
                for (int n = 0; n < 2; ++n) { const f32x4 g4 = PG8_AG(acc, ai, 0, m, n), u4 = PG8_AG(acc, ai, 1, m, n);
#pragma unroll
                    for (int p = 0; p < 2; ++p) { const f32x2 g2 = {g4[2 * p], g4[2 * p + 1]}, u2 = {u4[2 * p], u4[2 * p + 1]};
                        const f32x2 t2 = g2 * tn2; const f32x2 e2 = {__builtin_amdgcn_exp2f(t2.x), __builtin_amdgcn_exp2f(t2.y)};
                        const f32x2 d2 = __builtin_elementwise_fma(e2, ic2, ic2); const f32x2 r2 = {__builtin_amdgcn_rcpf(d2.x), __builtin_amdgcn_rcpf(d2.y)};
                        const f32x2 h2 = (g2 * u2) * r2; h[4 * n + 2 * p] = h2.x; h[4 * n + 2 * p + 1] = h2.y; } }
                if (F8) {
                    float c8[8];
#pragma unroll
                    for (int j = 0; j < 8; ++j) c8[j] = __builtin_amdgcn_fmed3f(h[j], -448.f, 448.f);
                    int w0 = 0, w1 = 0;
                    w0 = __builtin_amdgcn_cvt_pk_fp8_f32(c8[0], c8[1], w0, false); w0 = __builtin_amdgcn_cvt_pk_fp8_f32(c8[2], c8[3], w0, true);
                    w1 = __builtin_amdgcn_cvt_pk_fp8_f32(c8[4], c8[5], w1, false); w1 = __builtin_amdgcn_cvt_pk_fp8_f32(c8[6], c8[7], w1, true);
                    u32x2 w8; w8.x = (unsigned)w0; w8.y = (unsigned)w1; *(u32x2*)((unsigned char*)H + (size_t)row * ldh + col0) = w8;
                } else {
                    u32x4 w; w.x = cvt_pk_bf16(h[0], h[1]); w.y = cvt_pk_bf16(h[2], h[3]); w.z = cvt_pk_bf16(h[4], h[5]); w.w = cvt_pk_bf16(h[6], h[7]);
                    *(u32x4*)(H + (size_t)row * ldh + col0) = w; }
            }
    }
};
struct EpiRes {
    static constexpr int BMODE = 1, A_AUX = 0; static constexpr bool ALIGN = true, FP8 = false; static constexpr int NST = 0;
    bf16_t* xb; float* ssout; bf16_t* xout;
    __device__ __forceinline__ float pre_load(const Unit&, int) const { return 0.f; }
    __device__ __forceinline__ void pre_store(float, int, LAS unsigned char*, int) const {}
    __device__ __forceinline__ void operator()(const AccT& acc, const Unit& u, int wr, int wc, int fr, int fq, LAS unsigned char* lds, int tid, int) const {
        LAS float* P = (LAS float*)(lds + EPI_OFF);
        const int col0 = u.pn * BM + wc * 32 + 8 * fq;
#pragma unroll
        for (int ai = 0; ai < 2; ++ai) {
            u32x4 bb[4][2];
#pragma unroll
            for (int m = 0; m < 4; ++m)
#pragma unroll
                for (int bj = 0; bj < 2; ++bj) bb[m][bj] = *(const u32x4*)(xb + (size_t)(u.pm * BM + ai * HALF + wr * 64 + m * 16 + fr) * D + col0 + bj * HALF);
#pragma unroll
            for (int m = 0; m < 4; ++m) {
                const int r = ai * HALF + wr * 64 + m * 16 + fr; const size_t off = (size_t)(u.pm * BM + r) * D + col0;
                float q = 0.f;
#pragma unroll
                for (int bj = 0; bj < 2; ++bj) {
                    const u32x4 b = bb[m][bj];
                    const f32x4 v0 = PG8_AG(acc, ai, bj, m, 0) + (f32x4){bf_lo(b.x), bf_hi(b.x), bf_lo(b.y), bf_hi(b.y)}, v1 = PG8_AG(acc, ai, bj, m, 1) + (f32x4){bf_lo(b.z), bf_hi(b.z), bf_lo(b.w), bf_hi(b.w)};
                    u32x4 w; w.x = cvt_pk_bf16(v0[0], v0[1]); w.y = cvt_pk_bf16(v0[2], v0[3]); w.z = cvt_pk_bf16(v1[0], v1[1]); w.w = cvt_pk_bf16(v1[2], v1[3]);
                    *(u32x4*)(xout + off + bj * HALF) = w;
                    q += (v0[0] * v0[0] + v0[1] * v0[1]) + (v0[2] * v0[2] + v0[3] * v0[3]) + (v1[0] * v1[0] + v1[1] * v1[1]) + (v1[2] * v1[2] + v1[3] * v1[3]); }
                q = xor32_sum(xor16_sum(q));
                if (fq == 0) P[r * 4 + wc] = q;
            }
        }
        LDS_WAIT(); __builtin_amdgcn_s_barrier(); asm volatile("" ::: "memory");
        if (tid < 256) { const f32x4 p = *(const LAS f32x4*)(P + tid * 4); ssout[(size_t)(u.pm * BM + tid) * 4 + u.pn] = (p.x + p.y) + (p.z + p.w); }
        LDS_WAIT();
    }
};
struct EpiMoeDown {
    static constexpr int BMODE = 1, A_AUX = 0; static constexpr bool ALIGN = true, FP8 = true; static constexpr int NST = 0;
    bf16_t* y1; bf16_t* y2; bf16_t* yx; const unsigned* rowtok; const float* rowgate; const volatile LAS int* T;
    __device__ __forceinline__ float pre_load(const Unit&, int) const { return 0.f; }
    __device__ __forceinline__ void pre_store(float, int, LAS unsigned char*, int) const {}
    __device__ __forceinline__ void operator()(const AccT& acc, const Unit& u, int wr, int wc, int fr, int fq, LAS unsigned char*, int, int) const {
        const int col0 = u.pn * BM + wc * 32 + 8 * fq; const int cnt = T[u.e];
        unsigned tkv[2][4]; float gtv[2][4];
#pragma unroll
        for (int ai = 0; ai < 2; ++ai)
#pragma unroll
            for (int m = 0; m < 4; ++m) { const int idx = u.lt * BM + ai * HALF + wr * 64 + m * 16 + fr; const bool ok = idx < cnt;
                tkv[ai][m] = ok ? rowtok[(size_t)u.e * CAP + idx] : 0u; gtv[ai][m] = ok ? rowgate[(size_t)u.e * CAP + idx] * (1.0f / (H8_SCALE * W8_SCALE)) : 0.f; }
#pragma unroll
        for (int ai = 0; ai < 2; ++ai)
#pragma unroll
            for (int m = 0; m < 4; ++m) {
                const int r = ai * HALF + wr * 64 + m * 16 + fr; const int idx = u.lt * BM + r;
                if (idx < cnt) {
                    const unsigned tk = tkv[ai][m]; const float gt = gtv[ai][m];
                    bf16_t* dst = u.aux >= 0 ? yx + (size_t)(u.aux * BM + r) * D + col0 : ((tk >> 31) ? y2 : y1) + (size_t)(tk & 0x7fffffffu) * D + col0;
#pragma unroll
                    for (int bj = 0; bj < 2; ++bj) { const f32x4 v0 = PG8_AG(acc, ai, bj, m, 0) * gt, v1 = PG8_AG(acc, ai, bj, m, 1) * gt;
                        u32x4 w; w.x = cvt_pk_bf16(v0[0], v0[1]); w.y = cvt_pk_bf16(v0[2], v0[3]); w.z = cvt_pk_bf16(v1[0], v1[1]); w.w = cvt_pk_bf16(v1[2], v1[3]);
                        *(u32x4*)(dst + bj * HALF) = w; }
                }
            }
    }
};
}
#define XB_TMO      128
#define XB_XCNT(j)  (256  + 64 * (j))
#define XB_XSUB(j)  (1280 + 64 * (j))
#define XB_XGEN(j)  (2304 + 64 * (j))
#define XB_TOP      3328
#define XB_TOPGEN   3392
#define XCD_BAR_WORDS 3456
#define XB_SPIN_CAP (1u << 18)

__device__ __forceinline__ unsigned xb_ld(unsigned* p)              { return __hip_atomic_load(p, __ATOMIC_RELAXED, __HIP_MEMORY_SCOPE_AGENT); }
__device__ __forceinline__ unsigned xb_add(unsigned* p, unsigned v) { return __hip_atomic_fetch_add(p, v, __ATOMIC_RELAXED, __HIP_MEMORY_SCOPE_AGENT); }
__device__ __forceinline__ unsigned xb_xcc_id() { return (unsigned)__builtin_amdgcn_s_getreg((3 << 11) | 20) & 0xFu; }
#define XB_SPIN(cond, bar) do { unsigned _sp = 0; while (cond) { __builtin_amdgcn_s_sleep(1); \
    if ((++_sp & 255u) == 0u) { if (xb_ld(&(bar)[XB_TMO])) break; if (_sp > XB_SPIN_CAP) { atomicAdd(&(bar)[XB_TMO], 1u); break; } } } } while (0)

struct XcdBarrier {
    unsigned* bar; unsigned x;
    volatile LAS unsigned* st;
};

__device__ __forceinline__ XcdBarrier xcd_barrier_post(unsigned* bar, volatile LAS unsigned* st) {
    XcdBarrier b; b.bar = bar; b.x = xb_xcc_id(); b.st = st;
    if (threadIdx.x == 0) (void)xb_add(&bar[XB_XCNT(b.x)], 1u);
    return b;
}
__device__ __forceinline__ void xcd_barrier_complete(unsigned* bar, unsigned x, unsigned& nloc, unsigned& nx) {
    const unsigned G = gridDim.x * gridDim.y * gridDim.z;
    unsigned sum, cnt, mine, sp = 0u;
    for (;;) {
        sum = 0u; cnt = 0u; mine = 0u;
#pragma unroll
        for (unsigned j = 0; j < 16; ++j) { const unsigned c = xb_ld(&bar[XB_XCNT(j)]); sum += c; cnt += (c > 0u) ? 1u : 0u; mine = (j == x) ? c : mine; }
        if (sum == G) break;
        __builtin_amdgcn_s_sleep(1);
        if ((++sp & 255u) == 0u) { if (xb_ld(&bar[XB_TMO])) break; if (sp > XB_SPIN_CAP) { atomicAdd(&bar[XB_TMO], 1u); break; } }
    }
    nloc = mine > 0u ? mine : 1u; nx = cnt > 0u ? cnt : 1u;
}

__device__ __forceinline__ void xcd_barrier(const XcdBarrier& b) {
    asm volatile("s_waitcnt vmcnt(0)" ::: "memory");
    __syncthreads();
    if (threadIdx.x == 0) {
        unsigned* bar = b.bar;
        __builtin_amdgcn_s_waitcnt(0);
        unsigned nloc = b.st[0], nx = b.st[1];
        if (nloc == 0u) { xcd_barrier_complete(bar, b.x, nloc, nx); b.st[0] = nloc; b.st[1] = nx; }
        const unsigned old = xb_add(&bar[XB_XSUB(b.x)], 1u);
        const unsigned gen = old / nloc;
        if (old + 1u == (gen + 1u) * nloc) {
            __builtin_amdgcn_fence(__ATOMIC_RELEASE, "agent");
            asm volatile("s_waitcnt vmcnt(0)" ::: "memory");
            const unsigned og = xb_add(&bar[XB_TOP], 1u);
            const unsigned tg = og / nx;
            if (og + 1u == (tg + 1u) * nx) xb_add(&bar[XB_TOPGEN], 1u);
            else XB_SPIN(xb_ld(&bar[XB_TOPGEN]) == tg, bar);
            __builtin_amdgcn_fence(__ATOMIC_ACQUIRE, "agent");
            xb_add(&bar[XB_XGEN(b.x)], 1u);
            asm volatile("s_waitcnt vmcnt(0)" ::: "memory");
        } else {
            XB_SPIN(xb_ld(&bar[XB_XGEN(b.x)]) == gen, bar);
            __builtin_amdgcn_fence(__ATOMIC_ACQUIRE, "agent");
            asm volatile("s_waitcnt vmcnt(0)" ::: "memory");
        }
    }
    __syncthreads();
}
namespace att {
constexpr int TILE_B = 8192;
__device__ __forceinline__ void glds16(const void* g, LAS unsigned char* l) { __builtin_amdgcn_global_load_lds((const unsigned*)g, (LAS unsigned*)l, 16, 0, 0); }
__device__ __forceinline__ s16x4 vtr(const LAS unsigned char* p) { typedef short v4i16_t __attribute__((ext_vector_type(4))); return __builtin_bit_cast(s16x4, __builtin_amdgcn_ds_read_tr16_b64_v4i16((LAS v4i16_t*)p)); }

__device__ __forceinline__ void stage_tile(LAS unsigned char* kt, LAS unsigned char* vt, const bf16_t* Kg, const bf16_t* Vg, int pitch, int ktok, int vtok, int wid, int lane) {
    const int c = (lane & 7) ^ ((4 * wid + (lane >> 4)) & 7);
    glds16(Kg + (size_t)ktok * pitch + c * 8, kt + wid * 1024);
    glds16(Vg + (size_t)vtok * pitch + (wid >> 2) * 32 + (lane & 3) * 8, vt + wid * 1024);
}
__device__ __forceinline__ void fetch_tile(u32x4& kreg, u32x4& vreg, const bf16_t* Kg, const bf16_t* Vg, int pitch, int ktok, int vtok, int wid, int lane) {
    const int c = (lane & 7) ^ ((4 * wid + (lane >> 4)) & 7);
    kreg = *(const u32x4*)(Kg + (size_t)ktok * pitch + c * 8);
    vreg = *(const u32x4*)(Vg + (size_t)vtok * pitch + (wid >> 2) * 32 + (lane & 3) * 8);
}
__device__ __forceinline__ void commit_tile(LAS unsigned char* kt, LAS unsigned char* vt, const u32x4& kreg, const u32x4& vreg, int wid, int lane) {
    *(LAS u32x4*)(kt + wid * 1024 + lane * 16) = kreg; *(LAS u32x4*)(vt + wid * 1024 + lane * 16) = vreg;
}
__device__ __forceinline__ int crow(int r) { return (r & 3) + 8 * (r >> 2); }

template <class CI, class PM>
__device__ __forceinline__ void half_step(const LAS unsigned char* kaddr, const unsigned (&so)[4], const LAS unsigned char* vb, const unsigned (&vo)[4], const bf16x8 (&qr)[4], f32x16 (&o)[2], float& lrun, const CI& ci, const PM& pm) {
    f32x16 p;
#pragma unroll
    for (int r = 0; r < 16; ++r) p[r] = ci(crow(r));
#pragma unroll
    for (int d0 = 0; d0 < 4; ++d0) p = __builtin_amdgcn_mfma_f32_32x32x16_bf16(*(const LAS bf16x8*)(kaddr + so[d0]), qr[d0], p, 0, 0, 0);
    float rs = 0.f;
#pragma unroll
    for (int r = 0; r < 16; ++r) { p[r] = __builtin_amdgcn_exp2f(pm(p[r], crow(r))); rs += p[r]; }
    lrun += rs;
    u32x4 pw0, pw1;
#pragma unroll
    for (int j = 0; j < 4; ++j) { pw0[j] = cvt_pk_bf16(p[2 * j], p[2 * j + 1]); pw1[j] = cvt_pk_bf16(p[8 + 2 * j], p[9 + 2 * j]); }
#pragma unroll
    for (int d0 = 0; d0 < 2; ++d0) {
        const s16x4 a0 = vtr(vb + vo[0] + d0 * 4096), a1 = vtr(vb + vo[1] + d0 * 4096), b0 = vtr(vb + vo[2] + d0 * 4096), b1 = vtr(vb + vo[3] + d0 * 4096);
        o[d0] = __builtin_amdgcn_mfma_f32_32x32x16_bf16((bf16x8){a0[0], a0[1], a0[2], a0[3], a1[0], a1[1], a1[2], a1[3]}, __builtin_bit_cast(bf16x8, pw0), o[d0], 0, 0, 0);
        o[d0] = __builtin_amdgcn_mfma_f32_32x32x16_bf16((bf16x8){b0[0], b0[1], b0[2], b0[3], b1[0], b1[1], b1[2], b1[3]}, __builtin_bit_cast(bf16x8, pw1), o[d0], 0, 0, 0);
    }
}
__device__ __forceinline__ void store_o(bf16_t* orow, const f32x16 (&o)[2], float inv, int hi) {
#pragma unroll
    for (int d0 = 0; d0 < 2; ++d0)
#pragma unroll
        for (int gq = 0; gq < 4; ++gq) { u32x2 w; w.x = cvt_pk_bf16(o[d0][4 * gq] * inv, o[d0][4 * gq + 1] * inv); w.y = cvt_pk_bf16(o[d0][4 * gq + 2] * inv, o[d0][4 * gq + 3] * inv);
            *(u32x2*)(orow + 32 * d0 + 8 * gq + 4 * hi) = w; }
}
template <bool FULL>
__device__ __forceinline__ void stage_o(LAS unsigned char* stg, const f32x16 (&o)[2], float inv, int r32, int hi) {
#pragma unroll
    for (int d0 = 0; d0 < 2; ++d0)
#pragma unroll
        for (int gq = 0; gq < 4; ++gq) { u32x2 w; w.x = cvt_pk_bf16(o[d0][4 * gq] * inv, o[d0][4 * gq + 1] * inv); w.y = cvt_pk_bf16(o[d0][4 * gq + 2] * inv, o[d0][4 * gq + 3] * inv);
            if (FULL) *(LAS u32x2*)(stg + r32 * 128 + (32 * d0 + 8 * gq + 4 * hi) * 2) = w; else *(LAS u32x2*)(stg + d0 * 2048 + r32 * 64 + (8 * gq + 4 * hi) * 2) = w; }
}
template <bool FULL, class RP>
__device__ __forceinline__ void flush_o(const LAS unsigned char* stg, int lane, const RP& rowptr) {
    if (FULL) {
#pragma unroll
        for (int i = 0; i < 4; ++i) { const int row = i * 8 + (lane >> 3), ch = lane & 7; const u32x4 v = *(const LAS u32x4*)(stg + row * 128 + ch * 16); *(u32x4*)(rowptr(row) + ch * 8) = v; }
    } else {
#pragma unroll
        for (int d0 = 0; d0 < 2; ++d0)
#pragma unroll
            for (int i = 0; i < 2; ++i) { const int row = i * 16 + (lane >> 2), ch = lane & 3; const u32x4 v = *(const LAS u32x4*)(stg + d0 * 2048 + row * 64 + ch * 16); *(u32x4*)(rowptr(row) + 32 * d0 + ch * 8) = v; }
    }
}
struct HS { const LAS unsigned char* ka; const LAS unsigned char* vb; const LAS float* tb; };
template <int NT, class HSF>
__device__ __forceinline__ void pipe_rows(const HSF& hsf, const unsigned (&so)[4], const unsigned (&vo)[4], const bf16x8 (&qr)[4], f32x16 (&o)[2], float& lrun, const int wm) {
#define ATT_SB() __builtin_amdgcn_sched_barrier(0)
#define ATT_E(r) do { const float x_ = __builtin_amdgcn_exp2f(pc[r]); pc[r] = __builtin_bit_cast(float, __builtin_bit_cast(unsigned, x_) & (unsigned)__builtin_amdgcn_sbfe(wm, crow(r), 1)); rs += pc[r]; } while (0)
#define ATT_KF(d0) (*(const LAS bf16x8*)(hn.ka + so[d0]))
#define ATT_V8(a_, b_) ((bf16x8){a_[0], a_[1], a_[2], a_[3], b_[0], b_[1], b_[2], b_[3]})
    f32x16 pc;
    { const HS h = hsf(0);
#pragma unroll
      for (int r = 0; r < 16; ++r) pc[r] = h.tb[crow(r)];
#pragma unroll
      for (int d0 = 0; d0 < 4; ++d0) pc = __builtin_amdgcn_mfma_f32_32x32x16_bf16(*(const LAS bf16x8*)(h.ka + so[d0]), qr[d0], pc, 0, 0, 0); }
#pragma unroll
    for (int t = 0; t < NT; ++t) {
        const bool more = t + 1 < NT;
        const HS h = hsf(t); const HS hn = hsf(more ? t + 1 : t);
        f32x16 pn; bf16x8 k0, k1; float rs = 0.f;
        if (more) {
#pragma unroll
            for (int r = 0; r < 16; ++r) pn[r] = hn.tb[crow(r)];
            k0 = ATT_KF(0); k1 = ATT_KF(1);
        }
        const s16x4 a00 = vtr(h.vb + vo[0]), a01 = vtr(h.vb + vo[1]), a10 = vtr(h.vb + vo[0] + 4096), a11 = vtr(h.vb + vo[1] + 4096);
        ATT_SB();
        if (more) pn = __builtin_amdgcn_mfma_f32_32x32x16_bf16(k0, qr[0], pn, 0, 0, 0);
        if (more) k0 = ATT_KF(2);
        ATT_E(0); ATT_E(1); ATT_E(2); ATT_E(3);
        ATT_SB();
        if (more) pn = __builtin_amdgcn_mfma_f32_32x32x16_bf16(k1, qr[1], pn, 0, 0, 0);
        if (more) k1 = ATT_KF(3);
        const s16x4 b00 = vtr(h.vb + vo[2]), b01 = vtr(h.vb + vo[3]), b10 = vtr(h.vb + vo[2] + 4096), b11 = vtr(h.vb + vo[3] + 4096);
        ATT_E(4); ATT_E(5); ATT_E(6); ATT_E(7);
        u32x4 pw0, pw1;
#pragma unroll
        for (int j = 0; j < 4; ++j) pw0[j] = cvt_pk_bf16(pc[2 * j], pc[2 * j + 1]);
        ATT_SB();
        if (more) pn = __builtin_amdgcn_mfma_f32_32x32x16_bf16(k0, qr[2], pn, 0, 0, 0);
        o[0] = __builtin_amdgcn_mfma_f32_32x32x16_bf16(ATT_V8(a00, a01), __builtin_bit_cast(bf16x8, pw0), o[0], 0, 0, 0);
        ATT_E(8); ATT_E(9); ATT_E(10); ATT_E(11);
        ATT_SB();
        if (more) pn = __builtin_amdgcn_mfma_f32_32x32x16_bf16(k1, qr[3], pn, 0, 0, 0);
        o[1] = __builtin_amdgcn_mfma_f32_32x32x16_bf16(ATT_V8(a10, a11), __builtin_bit_cast(bf16x8, pw0), o[1], 0, 0, 0);
        ATT_E(12); ATT_E(13); ATT_E(14); ATT_E(15);
#pragma unroll
        for (int j = 0; j < 4; ++j) pw1[j] = cvt_pk_bf16(pc[8 + 2 * j], pc[9 + 2 * j]);
        lrun += rs;
        ATT_SB();
        o[0] = __builtin_amdgcn_mfma_f32_32x32x16_bf16(ATT_V8(b00, b01), __builtin_bit_cast(bf16x8, pw1), o[0], 0, 0, 0);
        o[1] = __builtin_amdgcn_mfma_f32_32x32x16_bf16(ATT_V8(b10, b11), __builtin_bit_cast(bf16x8, pw1), o[1], 0, 0, 0);
        if (more) pc = pn;
    }
#undef ATT_SB
#undef ATT_E
#undef ATT_KF
#undef ATT_V8
}
struct TabCI { const LAS float* tb; __device__ __forceinline__ float operator()(int kc) const { return tb[kc]; } };
struct NoPM { __device__ __forceinline__ float operator()(float t, int) const { return t; } };
struct WinPM {
    int wm;
    __device__ __forceinline__ float operator()(float t, int kc) const {
        const int m = __builtin_amdgcn_sbfe(wm, kc, 1);
        return __builtin_bit_cast(float, (__builtin_bit_cast(unsigned, t) & (unsigned)m) | (~(unsigned)m & 0xff800000u)); }
};
__device__ __forceinline__ float wave_max(float v) {
#pragma unroll
    for (int o = 1; o < 64; o <<= 1) v = fmaxf(v, __shfl_xor(v, o));
    return v;
}
__device__ __forceinline__ float qk_bound(const float* gq, const float* gk, int lane) { return 64.f * C2 * wave_max(fabsf(gq[lane])) * wave_max(fabsf(gk[lane])); }
}
struct Args { const float* in[24]; float* out; unsigned char* ws; int ph_lo, ph_hi, li, pad; };
typedef Args Ptrs;
constexpr int NWAVES = 8;

struct ConvItem { const float* W; const float* gain; bf16_t* WT; int N, Kd, k0, n0, drow0, f8; };
__device__ __forceinline__ void conv_load(f32x4 (&v)[16], const ConvItem& it, int lane) {
    const float* src = it.W + (size_t)(it.k0 + (lane >> 4)) * it.N + it.n0 + 4 * (lane & 15);
#pragma unroll
    for (int i = 0; i < 16; ++i) v[i] = __builtin_nontemporal_load((const f32x4*)(src + (size_t)(4 * i) * it.N));
}
__device__ __forceinline__ void conv_to_lds(const f32x4 (&v)[16], const ConvItem& it, LAS float* scr, int lane) {
#pragma unroll
    for (int i = 0; i < 16; ++i) { const int kk = 4 * i + (lane >> 4); const float gk = it.gain ? it.gain[it.k0 + kk] : 1.f; LAS float* d = scr + kk * 65 + 4 * (lane & 15);
        d[0] = v[i].x * gk; d[1] = v[i].y * gk; d[2] = v[i].z * gk; d[3] = v[i].w * gk; }
    LDS_WAIT(); asm volatile("" ::: "memory");
}
__device__ __forceinline__ void conv_from_lds(const ConvItem& it, LAS float* scr, int lane) {
    const int c = lane & 7;
#pragma unroll
    for (int j = 0; j < 8; ++j) { const int n = (lane >> 3) + 8 * j; const LAS float* s = scr + (8 * c) * 65 + n;
        u32x4 o; o.x = pk2(s[0 * 65], s[1 * 65]); o.y = pk2(s[2 * 65], s[3 * 65]); o.z = pk2(s[4 * 65], s[5 * 65]); o.w = pk2(s[6 * 65], s[7 * 65]);
        __builtin_nontemporal_store(o, (u32x4*)(it.WT + (size_t)(it.drow0 + n) * it.Kd + it.k0 + 8 * c)); }
    LDS_WAIT(); asm volatile("" ::: "memory");
}
__device__ __forceinline__ void conv_from_lds8(const ConvItem& it, LAS float* scr, int lane) {
    const int c = lane & 3; unsigned char* WT8 = (unsigned char*)it.WT;
#pragma unroll
    for (int j = 0; j < 4; ++j) { const int n = (lane >> 2) + 16 * j; const LAS float* s = scr + (16 * c) * 65 + n;
        u32x4 o;
#pragma unroll
        for (int q = 0; q < 4; ++q) { int w = 0;
            w = __builtin_amdgcn_cvt_pk_fp8_f32(s[(4 * q + 0) * 65] * W8_SCALE, s[(4 * q + 1) * 65] * W8_SCALE, w, false);
            w = __builtin_amdgcn_cvt_pk_fp8_f32(s[(4 * q + 2) * 65] * W8_SCALE, s[(4 * q + 3) * 65] * W8_SCALE, w, true); o[q] = (unsigned)w; }
        __builtin_nontemporal_store(o, (u32x4*)(WT8 + (size_t)(it.drow0 + n) * it.Kd + it.k0 + 16 * c)); }
    LDS_WAIT(); asm volatile("" ::: "memory");
}
__device__ __forceinline__ void conv_out(const ConvItem& it, LAS float* scr, int lane) { if (it.f8) conv_from_lds8(it, scr, lane); else conv_from_lds(it, scr, lane); }
__device__ __forceinline__ ConvItem conv_matrix_item(const float* W, int K, int N, const float* gain, bf16_t* WT, int ileave, int item) {
    const int nnb = N / 64, kb = item / nnb, nb = item % nnb, n0 = 64 * nb;
    ConvItem it; it.W = W; it.gain = gain; it.WT = WT; it.N = N; it.Kd = K; it.k0 = 64 * kb; it.n0 = n0; it.f8 = 0;
    it.drow0 = ileave == 0 ? n0 : ((n0 >> 7) * 256 + (n0 & 127) + (ileave == 2 ? 128 : 0));
    return it;
}
__device__ __forceinline__ ConvItem p0_expert_item(const Ptrs& P, int r) {
    unsigned char* ws = P.ws;
    constexpr int I_GE = (D / 64) * (FFE / 64), I_DE = (FFE / 64) * (D / 64);
    const int per_e = 2 * I_GE + I_DE; const int e = r / per_e; r -= e * per_e;
    if (r < I_GE) { ConvItem c = conv_matrix_item(P.in[21] + (size_t)e * D * FFE, D, FFE, P.in[19], (bf16_t*)(ws + WS_WGUE + (size_t)e * 2 * FFE * D), 1, r); c.f8 = 1; return c; } r -= I_GE;
    if (r < I_GE) { ConvItem c = conv_matrix_item(P.in[22] + (size_t)e * D * FFE, D, FFE, P.in[19], (bf16_t*)(ws + WS_WGUE + (size_t)e * 2 * FFE * D), 2, r); c.f8 = 1; return c; } r -= I_GE;
    { ConvItem c = conv_matrix_item(P.in[23] + (size_t)e * FFE * D, FFE, D, nullptr, (bf16_t*)(ws + WS_WDE + (size_t)e * D * FFE), 0, r); c.f8 = 1; return c; }
}
constexpr int P0_DEFER_A = 192 * 8 * 3, P0_DEFER_B = 128 * 8 * 3, P0_C_PER_WAVE = 16, P0_DEFER_C = 256 * 4 * P0_C_PER_WAVE, P0_DEFER = P0_DEFER_A + P0_DEFER_B;
__device__ __forceinline__ ConvItem p0_item(const Ptrs& P, int r) {
    unsigned char* ws = P.ws;
    constexpr int I_IN = (D / 64) * (N_IN0 / 64), I_O = (D / 64) * (D / 64), I_G0 = (D / 64) * (FF0 / 64), I_D0 = (FF0 / 64) * (D / 64), I_Q1 = (D / 64) * (N_QKV1 / 64);
    constexpr int I_E = NE * 3 * (D / 64) * (FFE / 64), I_E1 = I_E - P0_DEFER_B, I_DENSE = 2 * I_O + 2 * I_G0 + I_D0 + I_Q1;
    if (r < I_IN) return conv_matrix_item(P.in[2], D, N_IN0, P.in[1], (bf16_t*)(ws + WS_WIN), 0, r); r -= I_IN;
    if (r < I_E1) return p0_expert_item(P, r); r -= I_E1;
    if (r >= I_DENSE) return p0_expert_item(P, I_E1 + r - I_DENSE);
    if (r < I_O) return conv_matrix_item(P.in[8], D, D, nullptr, (bf16_t*)(ws + WS_WOUT0), 0, r); r -= I_O;
    if (r < I_G0) return conv_matrix_item(P.in[10], D, FF0, P.in[9], (bf16_t*)(ws + WS_WGU0), 1, r); r -= I_G0;
    if (r < I_G0) return conv_matrix_item(P.in[11], D, FF0, P.in[9], (bf16_t*)(ws + WS_WGU0), 2, r); r -= I_G0;
    if (r < I_D0) return conv_matrix_item(P.in[12], FF0, D, nullptr, (bf16_t*)(ws + WS_WD0), 0, r); r -= I_D0;
    if (r < I_Q1) return conv_matrix_item(P.in[14], D, N_QKV1, P.in[13], (bf16_t*)(ws + WS_WQKV1), 0, r); r -= I_Q1;
    return conv_matrix_item(P.in[18], D, D, nullptr, (bf16_t*)(ws + WS_WOUT1), 0, r);
}
constexpr int P0_ITEMS = (D / 64) * (N_IN0 / 64) + 2 * (D / 64) * (D / 64) + 3 * (D / 64) * (FF0 / 64) + (D / 64) * (N_QKV1 / 64) + NE * 3 * (D / 64) * (FFE / 64);
static_assert(P0_DEFER_A >= 2 * (D / 64) * (D / 64) + 3 * (D / 64) * (FF0 / 64) + (D / 64) * (N_QKV1 / 64), "block A holds every dense matrix but w_in");
static_assert(P0_ITEMS - P0_DEFER - P0_DEFER_C >= (D / 64) * (N_IN0 / 64), "block C holds expert (e4m3) items only; w_in stays in the prologue");
__device__ __forceinline__ void p0_tail_items(const Ptrs& P, LAS unsigned char* lds, int first, int n, int wave, int lane) {
    LAS float* scr = (LAS float*)(lds + wave * 16640); f32x4 v[16];
    for (int j = 0; j < n; ++j) { const ConvItem c = p0_item(P, first + j); conv_load(v, c, lane); conv_to_lds(v, c, scr, lane); conv_out(c, scr, lane); }
}
__device__ __forceinline__ void convr_load(f32x4 (&v)[16], float (&g)[16], const ConvItem& it, int lane) {
    const float* src = it.W + (size_t)(it.k0 + 16 * (lane >> 4)) * it.N + it.n0 + 4 * (lane & 15);
#pragma unroll
    for (int i = 0; i < 16; ++i) v[i] = __builtin_nontemporal_load((const f32x4*)(src + (size_t)i * it.N));
#pragma unroll
    for (int i = 0; i < 16; ++i) g[i] = it.gain ? it.gain[it.k0 + 16 * (lane >> 4) + i] : 1.f;
}
__device__ __forceinline__ void convr_out8(const f32x4 (&v)[16], const float (&g)[16], const ConvItem& it, int lane) {
    unsigned char* dst = (unsigned char*)it.WT + (size_t)(it.drow0 + 4 * (lane & 15)) * it.Kd + it.k0 + 16 * (lane >> 4);
#pragma unroll
    for (int j = 0; j < 4; ++j) { u32x4 o;
#pragma unroll
        for (int q = 0; q < 4; ++q) { int w = 0;
            w = __builtin_amdgcn_cvt_pk_fp8_f32(v[4 * q][j] * (g[4 * q] * W8_SCALE), v[4 * q + 1][j] * (g[4 * q + 1] * W8_SCALE), w, false);
            w = __builtin_amdgcn_cvt_pk_fp8_f32(v[4 * q + 2][j] * (g[4 * q + 2] * W8_SCALE), v[4 * q + 3][j] * (g[4 * q + 3] * W8_SCALE), w, true); o[q] = (unsigned)w; }
        __builtin_nontemporal_store(o, (u32x4*)(dst + (size_t)j * it.Kd)); }
}
__device__ __forceinline__ void p0_prologue(const Ptrs& P, LAS unsigned char* lds, int gw, int NGW, int wave, int lane, int G) {
    LAS float* scr = (LAS float*)(lds + wave * 16640);
    unsigned char* ws = P.ws;
    const int NITEMS = (G == 256) ? P0_ITEMS - P0_DEFER - P0_DEFER_C : P0_ITEMS;
    f32x4 va[16], vb[16];
    int it = gw;
    if (it < NITEMS) { const ConvItem c0 = p0_item(P, it); conv_load(va, c0, lane); }
#pragma unroll 1
    for (; it < NITEMS; it += 2 * NGW) {
        { const ConvItem c0 = p0_item(P, it); conv_to_lds(va, c0, scr, lane);
          if (it + NGW < NITEMS) { const ConvItem c1 = p0_item(P, it + NGW); conv_load(vb, c1, lane); }
          conv_out(c0, scr, lane); }
        if (it + NGW < NITEMS) { const ConvItem c1 = p0_item(P, it + NGW); conv_to_lds(vb, c1, scr, lane);
          if (it + 2 * NGW < NITEMS) { const ConvItem c2 = p0_item(P, it + 2 * NGW); conv_load(va, c2, lane); }
          conv_out(c1, scr, lane); }
    }
    const float* x = P.in[0]; bf16_t* xb = (bf16_t*)(ws + WS_XB); float* ss0 = (float*)(ws + WS_SS);
    for (int m = gw; m < M; m += NGW) {
        const f32x4* xr = (const f32x4*)(x + (size_t)m * D) + lane; f32x4 v[4]; float s = 0.f;
#pragma unroll
        for (int j = 0; j < 4; ++j) { v[j] = __builtin_nontemporal_load(xr + 64 * j); s += (v[j].x * v[j].x + v[j].y * v[j].y) + (v[j].z * v[j].z + v[j].w * v[j].w); }
        s = wave_sum(s);
        u32x2* o8 = (u32x2*)(xb + (size_t)m * D) + lane;
#pragma unroll
        for (int j = 0; j < 4; ++j) { u32x2 w; w.x = pk2(v[j].x, v[j].y); w.y = pk2(v[j].z, v[j].w); o8[64 * j] = w; }
        if (lane == 0) *(f32x4*)(ss0 + (size_t)m * 4) = (f32x4){s, 0.f, 0.f, 0.f};
    }
}

struct ADesc { int b, h, r, cfg, p, l0, seg, tokb; };
template <bool FINAL>
__device__ __forceinline__ ADesc decodeA(int a) {
    ADesc d; const int cfg = FINAL ? 2 : (a >> 9), rem = a & 511; d.cfg = cfg; d.b = rem >> 7; d.h = (rem >> 4) & 7; d.r = cfg == 0 ? 1 : (cfg == 1 ? 4 : 16);
    const int idx16 = rem & 15, nblk = 16 / d.r; d.p = idx16 / nblk; d.l0 = 256 * (idx16 % nblk); d.seg = SEQ / d.r; d.tokb = d.b * SEQ + d.p; return d; }
__device__ __forceinline__ void fetchA(const Ptrs& P, const ADesc& d, u32x4 (&kq)[6], u32x4 (&vq)[6], bf16x8 (&qn)[4], int wid, int lane) {
    const bf16_t* QKV = (const bf16_t*)(P.ws + WS_QKV); const bf16_t* Kg = QKV + (size_t)(8 + d.h) * M * 64; const bf16_t* Vg = QKV + (size_t)(16 + d.h) * M * 64;
#pragma unroll
    for (int t = 0; t < 6; ++t) {
        int kd = d.l0 - 64 + 64 * t + 8 * wid + (lane >> 3); kd = kd < 0 ? 0 : (kd > d.seg - 1 ? d.seg - 1 : kd);
        int vd = d.l0 - 64 + 64 * t + 16 * (wid & 3) + (lane >> 2); vd = vd < 0 ? 0 : (vd > d.seg - 1 ? d.seg - 1 : vd);
        att::fetch_tile(kq[t], vq[t], Kg, Vg, 64, d.tokb + kd * d.r, d.tokb + vd * d.r, wid, lane); }
    const int tok = d.tokb + (d.l0 + 32 * wid + (lane & 31)) * d.r;
#pragma unroll
    for (int d0 = 0; d0 < 4; ++d0) qn[d0] = *(const bf16x8*)(QKV + ((size_t)d.h * M + tok) * 64 + 16 * d0 + 8 * (lane >> 5));
}
__device__ __forceinline__ void fetchPart(const Ptrs& P, const ADesc& d, u32x2 (&pp)[16], float (&pl)[2], int wid, int lane) {
    const int hi = lane >> 5; const int tok = d.tokb + (d.l0 + 32 * wid + (lane & 31)) * d.r;
    const bf16_t* p1 = (const bf16_t*)(P.ws + WS_PA1) + (size_t)tok * 512 + d.h * 64; const bf16_t* p4 = (const bf16_t*)(P.ws + WS_PA4) + (size_t)tok * 512 + d.h * 64;
#pragma unroll
    for (int i = 0; i < 8; ++i) { const int c = 32 * (i >> 2) + 8 * (i & 3) + 4 * hi; pp[i] = *(const u32x2*)(p1 + c); pp[8 + i] = *(const u32x2*)(p4 + c); }
    const float* LS = (const float*)(P.ws + WS_LSE); pl[0] = LS[(size_t)tok * 8 + d.h]; pl[1] = LS[(size_t)M * 8 + (size_t)tok * 8 + d.h];
}
template <bool FINAL>
__device__ __forceinline__ void attnA_run(const Ptrs& P, LAS unsigned char* lds, int afirst, int astep, int aend, int wid, int lane, int tid) {
    const int r32 = lane & 31, hi = lane >> 5;
    LAS unsigned char* Kb = lds; LAS unsigned char* Vb = lds + 6 * att::TILE_B; LAS float* tab = (LAS float*)(lds + 12 * att::TILE_B);
    LAS unsigned char* stg = lds + 12 * att::TILE_B + 1024 + wid * 4096;
    if (afirst >= aend) return;
    const float shift = att::qk_bound(P.in[3], P.in[4], lane);
    unsigned so[4], vo[4];
    { const unsigned x = (unsigned)(r32 >> 1) & 7u;
#pragma unroll
      for (int d0 = 0; d0 < 4; ++d0) so[d0] = (((unsigned)(2 * d0 + hi)) ^ x) << 4;
      const unsigned vl = (unsigned)(((lane >> 4) & 1) * 32 + (lane & 3) * 8 + (4 * hi + ((lane & 15) >> 2)) * 64);
      vo[0] = vl; vo[1] = vl + 512u; vo[2] = vl + 1024u; vo[3] = vl + 1536u; }
    u32x4 kq[6], vq[6]; bf16x8 qn[4]; u32x2 pp[16]; float pl[2] = {0.f, 0.f};
    { const ADesc d0_ = decodeA<FINAL>(afirst); fetchA(P, d0_, kq, vq, qn, wid, lane); if (FINAL) fetchPart(P, d0_, pp, pl, wid, lane); }
    bf16_t* prow = nullptr; int prstep = 0; float* pls = nullptr; float plv = 0.f;
#pragma unroll 1
    for (int a = afirst; a < aend; a += astep) {
        const ADesc d = decodeA<FINAL>(a);
#pragma unroll
        for (int t = 0; t < 6; ++t) att::commit_tile(Kb + t * att::TILE_B, Vb + t * att::TILE_B, kq[t], vq[t], wid, lane);
        bf16x8 qr[4];
#pragma unroll
        for (int d0 = 0; d0 < 4; ++d0) qr[d0] = qn[d0];
        u32x2 pc[16]; float plc[2];
        if (FINAL) {
#pragma unroll
            for (int i = 0; i < 16; ++i) pc[i] = pp[i];
            plc[0] = pl[0]; plc[1] = pl[1]; }
        const float cs = __builtin_amdgcn_exp2f(-(float)(2 * d.h + 1) * 0.5f) * (float)d.r * LOG2E;
        if (tid < 256) { const float ad = fabsf((float)(128 - tid)); tab[tid] = ad <= 64.f ? -cs * ad - shift : -INFINITY; }
        LDS_WAIT(); __syncthreads();
        if (prow) { att::flush_o<true>(stg, lane, [&](int row) { return prow + (size_t)row * prstep; }); if (!FINAL && hi == 0) *pls = plv; }
        { const ADesc dn = decodeA<FINAL>(a + astep < aend ? a + astep : a); fetchA(P, dn, kq, vq, qn, wid, lane); if (FINAL) fetchPart(P, dn, pp, pl, wid, lane); }
        const int qd = d.l0 + 32 * wid + r32; const int tok = d.tokb + qd * d.r;
        f32x16 o[2];
#pragma unroll
        for (int i = 0; i < 16; ++i) { o[0][i] = 0.f; o[1][i] = 0.f; }
        float lrun = 0.f;
#pragma unroll 1
        for (int hs = 0; hs < 5; ++hs) {
            const int hh = wid + hs, ks0 = d.l0 - 64 + 32 * hh;
            if (ks0 < 0 || ks0 >= d.seg) continue;
            att::TabCI ci; ci.tb = tab + (128 - (qd - ks0 - 4 * hi));
            att::half_step(Kb + (32 * hh + r32) * 128, so, Vb + (hh >> 1) * att::TILE_B + (hh & 1) * 2048, vo, qr, o, lrun, ci, att::NoPM{});
        }
        const float ltot = lrun + __shfl_xor(lrun, 32);
        if (!FINAL) {
            att::stage_o<true>(stg, o, 1.0f, r32, hi);
            prow = (bf16_t*)(P.ws + (d.cfg == 0 ? WS_PA1 : WS_PA4)) + (size_t)(d.tokb + (d.l0 + 32 * wid) * d.r) * 512 + d.h * 64; prstep = d.r * 512;
            pls = (float*)(P.ws + WS_LSE) + (size_t)d.cfg * M * 8 + (size_t)tok * 8 + d.h; plv = ltot;
        } else {
            const float inv = 1.0f / (ltot + plc[0] + plc[1]);
#pragma unroll
            for (int i = 0; i < 8; ++i) { const int d0 = i >> 2, gq = i & 3; const u32x2 a_ = pc[i], bq = pc[8 + i];
                o[d0][4 * gq] += bf_lo(a_.x) + bf_lo(bq.x); o[d0][4 * gq + 1] += bf_hi(a_.x) + bf_hi(bq.x); o[d0][4 * gq + 2] += bf_lo(a_.y) + bf_lo(bq.y); o[d0][4 * gq + 3] += bf_hi(a_.y) + bf_hi(bq.y); }
            att::stage_o<true>(stg, o, inv, r32, hi);
            prow = (bf16_t*)(P.ws + WS_AO) + (size_t)(d.tokb + (d.l0 + 32 * wid) * d.r) * D + d.h * 64; prstep = d.r * D;
        }
        LDS_WAIT(); __syncthreads();
    }
    if (prow) { att::flush_o<true>(stg, lane, [&](int row) { return prow + (size_t)row * prstep; }); if (!FINAL && hi == 0) *pls = plv; }
    __syncthreads();
}
__device__ __forceinline__ void fetchB(const Ptrs& P, int u, u32x4 (&kq)[5], u32x4 (&vq)[5], bf16x8 (&qn)[4], int wid, int lane) {
    const int b = u >> 7, kvh = (u >> 6) & 1, q0 = 64 * (u & 63), tokb = b * SEQ;
    const bf16_t* QKV = (const bf16_t*)(P.ws + WS_QKV); const bf16_t* Kg = QKV + (size_t)(32 + kvh) * M * 64; const bf16_t* Vg = QKV + (size_t)(34 + kvh) * M * 64;
#pragma unroll
    for (int t = 0; t < 5; ++t) {
        int kd = q0 - 128 + 64 * t + 8 * wid + (lane >> 3); kd = kd < 0 ? 0 : (kd > SEQ - 1 ? SEQ - 1 : kd);
        int vd = q0 - 128 + 64 * t + 16 * (wid & 3) + (lane >> 2); vd = vd < 0 ? 0 : (vd > SEQ - 1 ? SEQ - 1 : vd);
        att::fetch_tile(kq[t], vq[t], Kg, Vg, 64, tokb + kd, tokb + vd, wid, lane); }
    const int hq = 4 * kvh + (wid & 3), tok = tokb + q0 + 32 * (wid >> 2) + (lane & 31);
#pragma unroll
    for (int d0 = 0; d0 < 4; ++d0) qn[d0] = *(const bf16x8*)(QKV + ((size_t)(24 + hq) * M + tok) * 64 + 16 * d0 + 8 * (lane >> 5));
}
__device__ __forceinline__ void attnB_run(const Ptrs& P, LAS unsigned char* lds, int ufirst, int ustep, int uend, int wid, int lane, int tid) {
    const int r32 = lane & 31, hi = lane >> 5;
    LAS unsigned char* Kb = lds; LAS unsigned char* Vb = lds + 5 * att::TILE_B; LAS float* tab = (LAS float*)(lds + 10 * att::TILE_B);
    LAS unsigned char* stg = lds + 10 * att::TILE_B + 6144 + wid * 4096;
    if (ufirst >= uend) return;
    const float shift = att::qk_bound(P.in[5], P.in[6], lane);
    unsigned so[4], vo[4];
    { const unsigned x = (unsigned)(r32 >> 1) & 7u;
#pragma unroll
      for (int d0 = 0; d0 < 4; ++d0) so[d0] = (((unsigned)(2 * d0 + hi)) ^ x) << 4;
      const unsigned vl = (unsigned)(((lane >> 4) & 1) * 32 + (lane & 3) * 8 + (4 * hi + ((lane & 15) >> 2)) * 64);
      vo[0] = vl; vo[1] = vl + 512u; vo[2] = vl + 1024u; vo[3] = vl + 1536u; }
    u32x4 kq[5], vq[5]; bf16x8 qn[4];
    const float sink0 = __builtin_amdgcn_exp2f(P.in[7][wid & 3] * LOG2E - shift), sink1 = __builtin_amdgcn_exp2f(P.in[7][4 + (wid & 3)] * LOG2E - shift);
    fetchB(P, ufirst, kq, vq, qn, wid, lane);
    bf16_t* prow = nullptr;
#pragma unroll 1
    for (int u = ufirst; u < uend; u += ustep) {
        const int b = u >> 7, kvh = (u >> 6) & 1, q0 = 64 * (u & 63), tokb = b * SEQ;
#pragma unroll
        for (int t = 0; t < 5; ++t) att::commit_tile(Kb + t * att::TILE_B, Vb + t * att::TILE_B, kq[t], vq[t], wid, lane);
        bf16x8 qr[4];
#pragma unroll
        for (int d0 = 0; d0 < 4; ++d0) qr[d0] = qn[d0];
#pragma unroll
        for (int i = 0; i < 3; ++i) { const int e = tid + 512 * i, hd_ = e / 384, y = e - hd_ * 384; const float ad = fabsf((float)(192 - y));
            const float csl = __builtin_amdgcn_exp2f(-(float)(4 * kvh + hd_ + 1)) * LOG2E;
            tab[e] = ad <= 128.f ? -csl * ad - shift : -INFINITY; }
        const int hd = wid & 3, hq = 4 * kvh + hd; const int qd = q0 + 32 * (wid >> 2) + r32;
        const float sinkp = kvh ? sink1 : sink0;
        LDS_WAIT(); __syncthreads();
        if (prow) att::flush_o<true>(stg, lane, [&](int row) { return prow + (size_t)row * D; });
        fetchB(P, u + ustep < uend ? u + ustep : u, kq, vq, qn, wid, lane);
        f32x16 o[2];
#pragma unroll
        for (int i = 0; i < 16; ++i) { o[0][i] = 0.f; o[1][i] = 0.f; }
        float lrun = hi == 0 ? sinkp : 0.f;
#pragma unroll 1
        for (int hs = 0; hs < 9; ++hs) {
            const int hh = (wid >> 2) + hs, ks0 = q0 - 128 + 32 * hh;
            if (ks0 < 0 || ks0 >= SEQ) continue;
            att::TabCI ci; ci.tb = tab + hd * 384 + (192 - (qd - ks0 - 4 * hi));
            att::half_step(Kb + (32 * hh + r32) * 128, so, Vb + (hh >> 1) * att::TILE_B + (hh & 1) * 2048, vo, qr, o, lrun, ci, att::NoPM{});
        }
        const float ltot = lrun + __shfl_xor(lrun, 32);
        att::stage_o<true>(stg, o, 1.0f / ltot, r32, hi);
        prow = (bf16_t*)(P.ws + WS_AO) + (size_t)(tokb + q0 + 32 * (wid >> 2)) * D + 512 + hq * 64;
        LDS_WAIT(); __syncthreads();
    }
    if (prow) att::flush_o<true>(stg, lane, [&](int row) { return prow + (size_t)row * D; });
    __syncthreads();
}
__device__ __forceinline__ void attnC_column(const Ptrs& P, LAS unsigned char* lds, int b, int h, int ip0, int nip, int wid, int lane, int tid, int cfirst) {
    const int r32 = lane & 31, hi = lane >> 5;
    const bf16_t* QKV = (const bf16_t*)(P.ws + WS_QKV);
    const bf16_t* Kg = QKV + (size_t)(16 + h) * M * 64; const bf16_t* Vg = QKV + (size_t)(32 + h) * M * 64;
    const int tokb = b * SEQ;
    LAS unsigned char* Kb = lds; LAS unsigned char* Vb = lds + 9 * att::TILE_B; LAS float* tab = (LAS float*)(lds + RPB_OFF);
    const float shift = att::qk_bound(P.in[15], P.in[16], lane);
#pragma unroll
    for (int i = 0; i < 2; ++i) { const int e = tid + 512 * i, row = e >> 6, co = (e & 63) - 16;
        tab[e] = (row < 15 && co >= 0 && co < 31) ? P.in[17][(size_t)h * 465 + row * 31 + co] * LOG2E - shift : -INFINITY; }
    int have;
    { const int i0 = 2 * ip0; const int rs0 = i0 - 4 < 0 ? 0 : (i0 - 4 > 56 ? 56 : i0 - 4); const int last = rs0 + 8 > 63 ? 63 : rs0 + 8;
#pragma unroll 1
      for (int kr = rs0; kr <= last; ++kr) { const int sl = kr % 9;
          att::stage_tile(Kb + sl * att::TILE_B, Vb + sl * att::TILE_B, Kg, Vg, 64, tokb + kr * 64 + 8 * wid + (lane >> 3), tokb + kr * 64 + 16 * (wid & 3) + (lane >> 2), wid, lane); }
      have = last; }
    u32x4 kn[2], vn[2]; int nnew = 0, newrow = 0;
#define ATTC_COMMIT() do { if (nnew > 0) att::commit_tile(Kb + (newrow % 9) * att::TILE_B, Vb + (newrow % 9) * att::TILE_B, kn[0], vn[0], wid, lane); \
        if (nnew > 1) att::commit_tile(Kb + ((newrow + 1) % 9) * att::TILE_B, Vb + ((newrow + 1) % 9) * att::TILE_B, kn[1], vn[1], wid, lane); } while (0)
#define ATTC_FETCH(i0_) do { nnew = 0; if (s + 1 < nip) { const int i1_ = (i0_) + 2; const int rs1_ = i1_ - 4 < 0 ? 0 : (i1_ - 4 > 56 ? 56 : i1_ - 4); const int last1_ = rs1_ + 8 > 63 ? 63 : rs1_ + 8; \
        nnew = last1_ - have; newrow = have + 1; \
        if (nnew > 0) att::fetch_tile(kn[0], vn[0], Kg, Vg, 64, tokb + newrow * 64 + 8 * wid + (lane >> 3), tokb + newrow * 64 + 16 * (wid & 3) + (lane >> 2), wid, lane); \
        if (nnew > 1) att::fetch_tile(kn[1], vn[1], Kg, Vg, 64, tokb + (newrow + 1) * 64 + 8 * wid + (lane >> 3), tokb + (newrow + 1) * 64 + 16 * (wid & 3) + (lane >> 2), wid, lane); \
        have = last1_; } } while (0)
    if (wid >= 4) {
        f32x4 cv[16], cw[16]; float cg[16], ch[16]; int pa = -1, pb = -1;
        VM_WAIT();
#pragma unroll 1
        for (int s = 0; s < nip; ++s) {
            const int i0 = 2 * (ip0 + s);
            ATTC_COMMIT();
            LDS_WAIT(); __syncthreads();
            ATTC_FETCH(i0);
            if (pa >= 0) { const ConvItem c = p0_item(P, pa); convr_out8(cv, cg, c, lane); }
            if (pb >= 0) { const ConvItem c = p0_item(P, pb); convr_out8(cw, ch, c, lane); }
            pa = (cfirst >= 0 && 2 * s < P0_C_PER_WAVE) ? cfirst + (wid - 4) * P0_C_PER_WAVE + 2 * s : -1;
            pb = (cfirst >= 0 && 2 * s + 1 < P0_C_PER_WAVE) ? cfirst + (wid - 4) * P0_C_PER_WAVE + 2 * s + 1 : -1;
            if (pa >= 0) { const ConvItem c = p0_item(P, pa); convr_load(cv, cg, c, lane); }
            if (pb >= 0) { const ConvItem c = p0_item(P, pb); convr_load(cw, ch, c, lane); }
            __syncthreads();
        }
        if (pa >= 0) { const ConvItem c = p0_item(P, pa); convr_out8(cv, cg, c, lane); }
        if (pb >= 0) { const ConvItem c = p0_item(P, pb); convr_out8(cw, ch, c, lane); }
    } else {
    LAS unsigned char* stg = lds + OSTAGE_OFF + (wid & 3) * 2048;
    const int cb = wid & 3;
    const int j = 16 * cb + (r32 & 15);
    const int cs0 = j - 8 < 0 ? 0 : (j - 8 > 48 ? 48 : j - 8);
    const int kcol0 = 16 * cb - 8 < 0 ? 0 : (16 * cb - 8 > 32 ? 32 : 16 * cb - 8);
    const int wm = (int)((0xFFFFu << (cs0 - kcol0)) >> (4 * hi));
    unsigned so[4], vo[4];
    { const unsigned x = (unsigned)((kcol0 + r32) >> 1) & 7u;
#pragma unroll
      for (int d0 = 0; d0 < 4; ++d0) so[d0] = (((unsigned)(2 * d0 + hi)) ^ x) << 4;
      const unsigned colb = (unsigned)(((lane >> 4) & 1) * 32 + (lane & 3) * 8);
#pragma unroll
      for (int m = 0; m < 4; ++m) { const int k = kcol0 + 8 * m + 4 * hi + ((lane & 15) >> 2); vo[m] = (unsigned)(((k >> 4) & 3) * 1024 + (k & 15) * 64) + colb; } }
    const int tb0 = kcol0 + 4 * hi - j + 31;
    bf16x8 qn[4];
    { const int tok = tokb + (2 * ip0 + (r32 >> 4)) * 64 + j;
#pragma unroll
      for (int d0 = 0; d0 < 4; ++d0) qn[d0] = *(const bf16x8*)(QKV + ((size_t)h * M + tok) * 64 + 16 * d0 + 8 * hi); }
    u32x2 opk[8]; bf16_t* prow = nullptr;
    VM_WAIT();
#pragma unroll 1
    for (int s = 0; s < nip; ++s) {
        const int i0 = 2 * (ip0 + s);
        const int rs0 = i0 - 4 < 0 ? 0 : (i0 - 4 > 56 ? 56 : i0 - 4);
        ATTC_COMMIT();
        bf16x8 qr[4];
#pragma unroll
        for (int d0 = 0; d0 < 4; ++d0) qr[d0] = qn[d0];
        LDS_WAIT(); __syncthreads();
        if (prow) {
#pragma unroll
            for (int d0 = 0; d0 < 2; ++d0) {
#pragma unroll
                for (int gq = 0; gq < 4; ++gq) *(LAS u32x2*)(stg + r32 * 64 + (8 * gq + 4 * hi) * 2) = opk[4 * d0 + gq];
                LDS_WAIT();
#pragma unroll
                for (int i = 0; i < 2; ++i) { const int row = i * 16 + (lane >> 2), ch = lane & 3; const u32x4 v = *(const LAS u32x4*)(stg + row * 64 + ch * 16);
                    *(u32x4*)(prow + (size_t)((row >> 4) * 64 + (row & 15)) * D + 32 * d0 + ch * 8) = v; }
                LDS_WAIT();
            }
        }
        ATTC_FETCH(i0);
        if (s + 1 < nip) {
            const int tok1 = tokb + (i0 + 2 + (r32 >> 4)) * 64 + j;
#pragma unroll
            for (int d0 = 0; d0 < 4; ++d0) qn[d0] = *(const bf16x8*)(QKV + ((size_t)h * M + tok1) * 64 + 16 * d0 + 8 * hi);
        }
        {
            const int qi = i0 + (r32 >> 4);
            f32x16 o[2];
#pragma unroll
            for (int q = 0; q < 16; ++q) { o[0][q] = 0.f; o[1][q] = 0.f; }
            float lrun = 0.f;
            const int rsi = qi - 4 < 0 ? 0 : (qi - 4 > 56 ? 56 : qi - 4);
            att::pipe_rows<9>([&](int t) { const int kr = rs0 + t; const int sl = kr % 9; const bool rowok = kr >= rsi && kr <= rsi + 7; const int ro = rowok ? kr - qi + 7 : 15;
                    att::HS hs; hs.ka = Kb + (sl * 64 + kcol0 + r32) * 128; hs.vb = Vb + sl * att::TILE_B; hs.tb = tab + ro * 64 + tb0; return hs; }, so, vo, qr, o, lrun, wm);
            const float inv = 1.0f / (lrun + __shfl_xor(lrun, 32));
#pragma unroll
            for (int i = 0; i < 8; ++i) { const int d0 = i >> 2, gq = i & 3; opk[i].x = cvt_pk_bf16(o[d0][4 * gq] * inv, o[d0][4 * gq + 1] * inv); opk[i].y = cvt_pk_bf16(o[d0][4 * gq + 2] * inv, o[d0][4 * gq + 3] * inv); }
            prow = (bf16_t*)(P.ws + WS_AO) + (size_t)(tokb + i0 * 64 + 16 * cb) * D + h * 64;
        }
        __syncthreads();
    }
    if (prow) {
#pragma unroll
        for (int d0 = 0; d0 < 2; ++d0) {
#pragma unroll
            for (int gq = 0; gq < 4; ++gq) *(LAS u32x2*)(stg + r32 * 64 + (8 * gq + 4 * hi) * 2) = opk[4 * d0 + gq];
            LDS_WAIT();
#pragma unroll
            for (int i = 0; i < 2; ++i) { const int row = i * 16 + (lane >> 2), ch = lane & 3; const u32x4 v = *(const LAS u32x4*)(stg + row * 64 + ch * 16);
                *(u32x4*)(prow + (size_t)((row >> 4) * 64 + (row & 15)) * D + 32 * d0 + ch * 8) = v; }
            LDS_WAIT();
        }
    }
    }
#undef ATTC_COMMIT
#undef ATTC_FETCH
    __syncthreads();
}

__device__ __forceinline__ void route_phase(const Ptrs& P, LAS unsigned char* lds, gu32* ctl, int bx, int G, int wave, int lane, int tid) {
    LAS float* wl = (LAS float*)lds;
    LAS unsigned* lc = (LAS unsigned*)(lds + 32768);
    LAS unsigned* rec = (LAS unsigned*)(lds + 32768 + 64);
    for (int i = tid; i < D * NE; i += NWAVES * 64) wl[i] = P.in[20][i] * P.in[19][i >> 3];
    if (tid < 16) lc[tid] = 0u;
    __syncthreads();
    unsigned* rowtok = (unsigned*)(P.ws + WS_ROWTOK); float* rowgate = (float*)(P.ws + WS_ROWGATE); float* rowrs = (float*)(P.ws + WS_ROWRS);
    f32x4 wreg[2][8][2];
#pragma unroll
    for (int jj = 0; jj < 2; ++jj)
#pragma unroll
        for (int c = 0; c < 8; ++c) { const LAS f32x4* w = (const LAS f32x4*)(wl + (size_t)(8 * (64 * jj + lane) + c) * 8); wreg[jj][c][0] = w[0]; wreg[jj][c][1] = w[1]; }
    for (int ch = bx; ch < M / 64; ch += G) {
        u32x4 xrow[8][2];
#pragma unroll
        for (int t = 0; t < 8; ++t) { const u32x4* xr = (const u32x4*)((const bf16_t*)(P.ws + WS_XB) + (size_t)(ch * 64 + wave * 8 + t) * D) + lane; xrow[t][0] = xr[0]; xrow[t][1] = xr[64]; }
#pragma unroll
        for (int t = 0; t < 8; ++t) {
            const int m = ch * 64 + wave * 8 + t;
            float s = 0.f; float a[8];
#pragma unroll
            for (int e = 0; e < 8; ++e) a[e] = 0.f;
#pragma unroll
            for (int jj = 0; jj < 2; ++jj) { const u32x4 xw = xrow[t][jj]; const float xv[8] = {bf_lo(xw.x), bf_hi(xw.x), bf_lo(xw.y), bf_hi(xw.y), bf_lo(xw.z), bf_hi(xw.z), bf_lo(xw.w), bf_hi(xw.w)};
                { int w0 = 0, w1 = 0;
                  float c8[8];
#pragma unroll
                  for (int q = 0; q < 8; ++q) c8[q] = __builtin_amdgcn_fmed3f(xv[q] * X8_SCALE, -448.f, 448.f);
                  w0 = __builtin_amdgcn_cvt_pk_fp8_f32(c8[0], c8[1], w0, false); w0 = __builtin_amdgcn_cvt_pk_fp8_f32(c8[2], c8[3], w0, true);
                  w1 = __builtin_amdgcn_cvt_pk_fp8_f32(c8[4], c8[5], w1, false); w1 = __builtin_amdgcn_cvt_pk_fp8_f32(c8[6], c8[7], w1, true);
                  u32x2 w8; w8.x = (unsigned)w0; w8.y = (unsigned)w1; *((u32x2*)(P.ws + WS_XB8 + (size_t)m * D) + 64 * jj + lane) = w8; }
#pragma unroll
                for (int c = 0; c < 8; ++c) { const f32x4 w0 = wreg[jj][c][0], w1 = wreg[jj][c][1]; const float x_ = xv[c]; s += x_ * x_;
                    a[0] += x_ * w0.x; a[1] += x_ * w0.y; a[2] += x_ * w0.z; a[3] += x_ * w0.w; a[4] += x_ * w1.x; a[5] += x_ * w1.y; a[6] += x_ * w1.z; a[7] += x_ * w1.w; } }
            s = wave_sum(s);
#pragma unroll
            for (int e = 0; e < 8; ++e) a[e] = wave_sum(a[e]);
            if (lane == 0) {
                const float rs = rsqrtf(s * (1.0f / D) + EPS);
                int e1 = 0; float v1 = a[0];
#pragma unroll
                for (int e = 1; e < 8; ++e) if (a[e] > v1) { v1 = a[e]; e1 = e; }
                int e2 = -1; float v2 = -INFINITY;
#pragma unroll
                for (int e = 0; e < 8; ++e) if (e != e1 && a[e] > v2) { v2 = a[e]; e2 = e; }
                const float g1 = 1.0f / (1.0f + __expf((v2 - v1) * rs)), g2 = 1.0f - g1;
                const unsigned s1 = __hip_atomic_fetch_add(lc + e1, 1u, __ATOMIC_RELAXED, __HIP_MEMORY_SCOPE_WORKGROUP);
                const unsigned s2 = __hip_atomic_fetch_add(lc + e2, 1u, __ATOMIC_RELAXED, __HIP_MEMORY_SCOPE_WORKGROUP);
                LAS unsigned* r = rec + (wave * 8 + t) * 4;
                r[0] = (unsigned)e1 | ((unsigned)e2 << 8) | (s1 << 16) | (s2 << 24); r[1] = __builtin_bit_cast(unsigned, rs); r[2] = __builtin_bit_cast(unsigned, g1); r[3] = __builtin_bit_cast(unsigned, g2);
            }
        }
        __syncthreads();
        if (tid < 8) lc[8 + tid] = __hip_atomic_fetch_add((unsigned*)(ctl + CW_CNT + 64 * tid), lc[tid], RLX_AGENT);
        __syncthreads();
        if (tid < 64) { const LAS unsigned* r = rec + tid * 4; const unsigned ee = r[0]; const int e1 = ee & 255u, e2 = (ee >> 8) & 255u; const unsigned m = (unsigned)(ch * 64 + tid);
            const unsigned p1 = lc[8 + e1] + ((ee >> 16) & 255u), p2 = lc[8 + e2] + (ee >> 24); const float rsv = __builtin_bit_cast(float, r[1]);
            rowtok[(size_t)e1 * CAP + p1] = m; rowgate[(size_t)e1 * CAP + p1] = __builtin_bit_cast(float, r[2]); rowrs[(size_t)e1 * CAP + p1] = rsv;
            rowtok[(size_t)e2 * CAP + p2] = m | 0x80000000u; rowgate[(size_t)e2 * CAP + p2] = __builtin_bit_cast(float, r[3]); rowrs[(size_t)e2 * CAP + p2] = rsv; }
        __syncthreads();
        if (tid < 8) lc[tid] = 0u;
        __syncthreads();
    }
}
#ifndef MK_N_LAUNCHES
#define MK_N_LAUNCHES 1
#endif
constexpr int N_PHASES = 14;
constexpr int N_LAUNCHES = MK_N_LAUNCHES;
static_assert(N_LAUNCHES == 1 || N_LAUNCHES == N_PHASES, "MK_N_LAUNCHES is 1 or 14");


__global__ void __launch_bounds__(NWAVES * 64, 2) fwd(Args args) {
    extern __shared__ __attribute__((aligned(16))) unsigned char lds_raw[];
    LAS unsigned char* lds = (LAS unsigned char*)lds_raw;
    volatile LAS unsigned* MISC = (volatile LAS unsigned*)(lds + MISC_OFF);
    const int tid = threadIdx.x, lane = tid & 63, wave = __builtin_amdgcn_readfirstlane(tid >> 6);
    const int G = gridDim.x, bx = blockIdx.x;
    const int gw = bx * NWAVES + wave, NGW = G * NWAVES;
    const int vcu = (G % 8 == 0) ? (bx % 8) * (G / 8) + bx / 8 : bx;
    const Args& P = args;
    unsigned char* ws = args.ws;
    gu32* ctl = (gu32*)(ws + WS_CTL);
    if (tid < 192) MISC[tid] = 0u;
    __syncthreads();
    XcdBarrier bar; bar.bar = (unsigned*)(ctl + CW_BAR); bar.x = 0; bar.st = nullptr;
    if (N_LAUNCHES == 1) bar = xcd_barrier_post((unsigned*)(ctl + CW_BAR), MISC + 8);
#define GRID_BAR() do { if (N_LAUNCHES == 1) xcd_barrier(bar); } while (0)
    const int lo = args.ph_lo, hi = args.ph_hi;
#ifndef PH_MASK
#define PH_MASK 0x3fff
#endif
#define IN(k) ((((PH_MASK) >> (k)) & 1) && lo <= (k) && (k) < hi)
#define BOTH(k) (IN(k) && IN((k) + 1))
    bf16_t* XB = (bf16_t*)(ws + WS_XB); bf16_t* QKV = (bf16_t*)(ws + WS_QKV); bf16_t* AO = (bf16_t*)(ws + WS_AO);
    float* SS = (float*)(ws + WS_SS);
    const volatile LAS int* T = (const volatile LAS int*)(MISC + 16);

    if (IN(0)) { p0_prologue(P, lds, gw, NGW, wave, lane, G); if (BOTH(0)) GRID_BAR(); }
    if (IN(1)) {
        pg8::Gemm g{XB, (const bf16_t*)(ws + WS_WIN), D}; pg8::DenseOrder S; S.init(M, N_IN0, D, G, bx);
        if (tid < 256) ((LAS float*)(lds + GN_OFF))[tid] = P.in[3 + (tid >> 6)][tid & 63];
        pg8::EpiQKV E{QKV, N_IN0, SS, 0};
        pg8::gemm_phase(lds, g, S, E);
        if (G == 256 && bx >= 64) p0_tail_items(P, lds, P0_ITEMS - P0_DEFER + ((bx - 64) * NWAVES + wave) * 3, 3, wave, lane);
        if (BOTH(1)) GRID_BAR();
    }
    if (IN(2)) {
        attnB_run(P, lds, vcu, G, 512, wave, lane, tid);
        attnA_run<false>(P, lds, vcu, G, 1024, wave, lane, tid);
        if (BOTH(2)) GRID_BAR();
    }
    if (IN(3)) {
        attnA_run<true>(P, lds, vcu, G, 512, wave, lane, tid);
        if (BOTH(3)) GRID_BAR();
    }
    if (IN(4)) {
        pg8::Gemm g{AO, (const bf16_t*)(ws + WS_WOUT0), D}; pg8::DenseOrder S; S.init(M, D, D, G, bx);
        pg8::EpiRes E{XB, SS + (size_t)1 * M * 4, XB};
        pg8::gemm_phase(lds, g, S, E);
        if (BOTH(4)) GRID_BAR();
    }
    if (IN(5)) {
        pg8::Gemm g{XB, (const bf16_t*)(ws + WS_WGU0), D}; pg8::DenseOrder S; S.init(M, 2 * FF0, D, G, bx);
        pg8::EpiSwi<false> E{(bf16_t*)(ws + WS_H0), FF0, SS + (size_t)1 * M * 4, nullptr, T};
        pg8::gemm_phase(lds, g, S, E);
        if (G == 256 && bx >= 128) p0_tail_items(P, lds, P0_ITEMS - P0_DEFER_B + ((bx - 128) * NWAVES + wave) * 3, 3, wave, lane);
        if (BOTH(5)) GRID_BAR();
    }
    if (IN(6)) {
        pg8::Gemm g{(const bf16_t*)(ws + WS_H0), (const bf16_t*)(ws + WS_WD0), FF0}; pg8::DenseOrder S; S.init(M, D, FF0, G, bx);
        pg8::EpiRes E{XB, SS + (size_t)2 * M * 4, XB};
        pg8::gemm_phase(lds, g, S, E);
        if (BOTH(6)) GRID_BAR();
    }
    if (IN(7)) {
        pg8::Gemm g{XB, (const bf16_t*)(ws + WS_WQKV1), D}; pg8::DenseOrder S; S.init(M, N_QKV1, D, G, bx);
        if (tid < 128) ((LAS float*)(lds + GN_OFF))[tid] = P.in[15 + (tid >> 6)][tid & 63];
        pg8::EpiQKV E{QKV, N_QKV1, SS + (size_t)2 * M * 4, 1};
        pg8::gemm_phase(lds, g, S, E);
        if (BOTH(7)) GRID_BAR();
    }
    if (IN(8)) {
        for (int w = vcu; w < 256; w += G) attnC_column(P, lds, w >> 6, (w >> 2) & 15, 8 * (w & 3), 8, wave, lane, tid, G == 256 ? P0_ITEMS - P0_DEFER - P0_DEFER_C + w * 4 * P0_C_PER_WAVE : -1);
        if (BOTH(8)) GRID_BAR();
    }
    if (IN(9)) {
        pg8::Gemm g{AO, (const bf16_t*)(ws + WS_WOUT1), D}; pg8::DenseOrder S; S.init(M, D, D, G, bx);
        pg8::EpiRes E{XB, SS + (size_t)3 * M * 4, XB};
        pg8::gemm_phase(lds, g, S, E);
        if (BOTH(9)) GRID_BAR();
    }
    if (IN(10)) { route_phase(P, lds, ctl, bx, G, wave, lane, tid); if (BOTH(10)) GRID_BAR(); }
    if (IN(11) || IN(12)) {
        if (tid == 0) { int t0 = 0, r0 = 0, x = 0;
            for (int e = 0; e < 8; ++e) { const int c = (int)__hip_atomic_load((unsigned*)(ctl + CW_CNT + 64 * e), RLX_AGENT); const int nt = (c + 255) >> 8;
                MISC[16 + e] = (unsigned)c; MISC[24 + e] = (unsigned)t0; MISC[35 + e] = (unsigned)r0; t0 += nt; r0 += nt < 16 ? nt : 16;
                for (int l = 16; l < nt; ++l) { if (x < 9) MISC[44 + x] = (unsigned)((e << 8) | l); ++x; } }
            MISC[32] = (unsigned)(t0 > MAXT ? MAXT : t0); MISC[43] = (unsigned)r0; MISC[33] = (unsigned)x;
            MISC[34] = (x >= 1 && x <= 9 && 28 * x <= G && 8 * x <= G && t0 <= MAXT) ? 1u : 0u; }
        __syncthreads();
    }
    const bool fast = T[18] != 0;
    volatile LAS unsigned* UL = (volatile LAS unsigned*)(lds + ULIST_OFF);
    LAS unsigned* TOKL = (LAS unsigned*)(lds + EPI_OFF);
    if (IN(11)) {
        pg8::Gemm g{(const bf16_t*)(ws + WS_XB8), (const bf16_t*)(ws + WS_WGUE), D / 2};
        pg8::EpiSwi<true> E{(bf16_t*)(ws + WS_HM), FFE, nullptr, (const float*)(ws + WS_ROWRS), T};
        if (fast) {
            { pg8::moe_build_list<1>(UL, T, 2 * FFE / 256, G, bx, 1, tid, (const unsigned*)(ws + WS_ROWTOK), TOKL); pg8::ListOrder S; S.init(UL, T, 2 * FFE, D / 2, 1, (const unsigned*)(ws + WS_ROWTOK), TOKL); pg8::gemm_phase(lds, g, S, E); }
            if (tid == 0) { __builtin_amdgcn_fence(__ATOMIC_RELEASE, "agent"); asm volatile("s_waitcnt vmcnt(0)" ::: "memory"); __hip_atomic_fetch_add((unsigned*)(ctl + CW_CA), 1u, RLX_AGENT); }
            if (bx < 4 * T[17]) {
                if (tid == 0) { unsigned sp = 0; while (__hip_atomic_load((unsigned*)(ctl + CW_CA), RLX_AGENT) < (unsigned)G && ++sp < (1u << 22)) __builtin_amdgcn_s_sleep(2);
                    __builtin_amdgcn_fence(__ATOMIC_ACQUIRE, "agent"); asm volatile("s_waitcnt vmcnt(0)" ::: "memory"); }
                __syncthreads();
                pg8::Gemm gd{(const bf16_t*)(ws + WS_HM), (const bf16_t*)(ws + WS_WDE), FFE / 2}; pg8::moe_build_list<3>(UL, T, D / 256, G, bx, 1, tid, nullptr, TOKL); pg8::ListOrder Sd; Sd.init(UL, T, D, FFE / 2, 0, nullptr, TOKL);
                pg8::EpiMoeDown Ed{(bf16_t*)(ws + WS_Y1), (bf16_t*)(ws + WS_Y2), (bf16_t*)(ws + WS_Y2X), (const unsigned*)(ws + WS_ROWTOK), (const float*)(ws + WS_ROWGATE), T};
                pg8::gemm_phase(lds, gd, Sd, Ed);
            }
        }
        { pg8::moe_build_list<2>(UL, T, 2 * FFE / 256, G, bx, fast ? 1 : 0, tid, (const unsigned*)(ws + WS_ROWTOK), TOKL); pg8::ListOrder S; S.init(UL, T, 2 * FFE, D / 2, 1, (const unsigned*)(ws + WS_ROWTOK), TOKL); pg8::gemm_phase(lds, g, S, E); }
        if (BOTH(11)) GRID_BAR();
    }
    if (IN(12)) {
        if (fast) {
            const int nrows = T[17] * 256; const unsigned* rowtok = (const unsigned*)(ws + WS_ROWTOK);
            for (int rr = gw; rr < nrows; rr += NGW) { const int k = rr >> 8, r = rr & 255, w = T[28 + k], e = w >> 8, idx = (w & 255) * 256 + r;
                if (idx < T[e]) { const unsigned tk = rowtok[(size_t)e * CAP + idx];
                    const u32x4* src = (const u32x4*)((const bf16_t*)(ws + WS_Y2X) + (size_t)rr * D); u32x4* dst = (u32x4*)((bf16_t*)(ws + ((tk >> 31) ? WS_Y2 : WS_Y1)) + (size_t)(tk & 0x7fffffffu) * D);
                    dst[lane] = src[lane]; dst[64 + lane] = src[64 + lane]; } }
        }
        pg8::Gemm g{(const bf16_t*)(ws + WS_HM), (const bf16_t*)(ws + WS_WDE), FFE / 2}; pg8::moe_build_list<4>(UL, T, D / 256, G, bx, fast ? 1 : 0, tid, nullptr, TOKL); pg8::ListOrder S; S.init(UL, T, D, FFE / 2, 0, nullptr, TOKL);
        pg8::EpiMoeDown E{(bf16_t*)(ws + WS_Y1), (bf16_t*)(ws + WS_Y2), (bf16_t*)(ws + WS_Y2X), (const unsigned*)(ws + WS_ROWTOK), (const float*)(ws + WS_ROWGATE), T};
        pg8::gemm_phase(lds, g, S, E);
        if (BOTH(12)) GRID_BAR();
    }
    if (IN(13)) {
        const bf16_t* y1 = (const bf16_t*)(ws + WS_Y1); const bf16_t* y2 = (const bf16_t*)(ws + WS_Y2);
        for (size_t i = ((size_t)bx * (NWAVES * 64) + tid) * 8; i < (size_t)M * D; i += (size_t)G * (NWAVES * 64) * 8) {
            const u32x4 x = __builtin_nontemporal_load((const u32x4*)(XB + i)), p = __builtin_nontemporal_load((const u32x4*)(y1 + i)), q = __builtin_nontemporal_load((const u32x4*)(y2 + i));
            const f32x4 a = (f32x4){bf_lo(x.x) + bf_lo(p.x) + bf_lo(q.x), bf_hi(x.x) + bf_hi(p.x) + bf_hi(q.x), bf_lo(x.y) + bf_lo(p.y) + bf_lo(q.y), bf_hi(x.y) + bf_hi(p.y) + bf_hi(q.y)};
            const f32x4 b = (f32x4){bf_lo(x.z) + bf_lo(p.z) + bf_lo(q.z), bf_hi(x.z) + bf_hi(p.z) + bf_hi(q.z), bf_lo(x.w) + bf_lo(p.w) + bf_lo(q.w), bf_hi(x.w) + bf_hi(p.w) + bf_hi(q.w)};
            __builtin_nontemporal_store(a, (f32x4*)(P.out + i)); __builtin_nontemporal_store(b, (f32x4*)(P.out + i + 4)); }
    }
#undef IN
#undef BOTH
#undef GRID_BAR
}

extern "C" void kernel_launch(void* const* d_in, const int* in_sizes, int n_in, void* d_out, int out_size, void* d_ws, size_t ws_size, hipStream_t stream) {
    static int grid = 0;
    if (grid == 0) {
        if (n_in != 24 || in_sizes[0] != M * D || out_size != M * D || ws_size < WS_END) { fprintf(stderr, "kernel_launch: unexpected shapes (n_in %d, in0 %d, out %d, ws %zu < %zu); nothing launched\n", n_in, n_in > 0 ? in_sizes[0] : -1, out_size, ws_size, (size_t)WS_END); grid = -1; return; }
        int dev = 0, cus = 0, per_cu = 0;
        if (hipGetDevice(&dev) != hipSuccess || hipDeviceGetAttribute(&cus, hipDeviceAttributeMultiprocessorCount, dev) != hipSuccess) { fprintf(stderr, "kernel_launch: device query failed\n"); grid = -1; return; }
        if (hipFuncSetAttribute((const void*)fwd, hipFuncAttributeMaxDynamicSharedMemorySize, LDS_BYTES) != hipSuccess) { fprintf(stderr, "kernel_launch: hipFuncSetAttribute(%d B LDS) failed\n", LDS_BYTES); grid = -1; return; }
        if (hipOccupancyMaxActiveBlocksPerMultiprocessor(&per_cu, (const void*)fwd, NWAVES * 64, LDS_BYTES) != hipSuccess || per_cu < 1) { fprintf(stderr, "kernel_launch: occupancy query reports %d workgroups per CU\n", per_cu); }
        (void)hipGetLastError();
        grid = cus;
    }
    if (grid < 0) return;
    if (hipMemsetAsync((char*)d_ws + WS_CTL, 0, CTL_ZERO_BYTES, stream) != hipSuccess) { fprintf(stderr, "kernel_launch: memset failed\n"); return; }
    Args a{};
    for (int i = 0; i < 24; ++i) a.in[i] = (const float*)d_in[i];
    a.out = (float*)d_out; a.ws = (unsigned char*)d_ws;
    for (int li = 0; li < N_LAUNCHES; ++li) {
        a.ph_lo = (N_LAUNCHES == 1) ? 0 : li; a.ph_hi = (N_LAUNCHES == 1) ? N_PHASES : li + 1; a.li = li; a.pad = 0;
        hipLaunchKernelGGL(fwd, dim3(grid), dim3(NWAVES * 64), LDS_BYTES, stream, a);
        const hipError_t le = hipPeekAtLastError();
        if (le != hipSuccess) { fprintf(stderr, "kernel_launch: launch %d failed: %s\n", li, hipGetErrorName(le)); break; }
    }
}
```

```cpp
#include <hip/hip_runtime.h>
#include <cstdio>
#include <cstdint>
#include <cmath>

#define LAS __attribute__((address_space(3)))
#define GAS __attribute__((address_space(1)))
typedef unsigned short bf16_t;
typedef short bf16x8 __attribute__((ext_vector_type(8)));
typedef short s16x4 __attribute__((ext_vector_type(4)));
typedef float f32x4 __attribute__((ext_vector_type(4)));
typedef float f32x2 __attribute__((ext_vector_type(2)));
typedef float f32x16 __attribute__((ext_vector_type(16)));
typedef unsigned u32x4 __attribute__((ext_vector_type(4)));
typedef unsigned u32x2 __attribute__((ext_vector_type(2)));
typedef GAS unsigned gu32;
#define RLX_AGENT __ATOMIC_RELAXED, __HIP_MEMORY_SCOPE_AGENT
#define LDS_WAIT() asm volatile("s_waitcnt lgkmcnt(0)" ::: "memory")
#define VM_WAIT() asm volatile("s_waitcnt vmcnt(0)" ::: "memory")

constexpr int D = 1024, SEQ = 4096, NB = 4, M = NB * SEQ, HD = 64;
constexpr int N_IN0 = 2304, FF0 = 2816, N_QKV1 = 3072, NE = 8, FFE = 3584;
constexpr float EPS = 1e-6f, LOG2E = 1.4426950408889634f, C2 = 0.125f * LOG2E;
constexpr float W8_SCALE = 32.f, X8_SCALE = 16.f, H8_SCALE = 4.f;
constexpr int CAP = 16384;
constexpr int MAXT = 136;

constexpr size_t MiB = 1u << 20;
constexpr size_t WS_CTL = 0, CTL_ZERO_BYTES = 32 * 1024;
constexpr size_t WS_ROWTOK = 1 * MiB;
constexpr size_t WS_ROWGATE = 2 * MiB;
constexpr size_t WS_ROWRS = 2 * MiB + 512 * 1024;
constexpr size_t WS_SS = 3 * MiB;
constexpr size_t WS_XB = 4 * MiB;
constexpr size_t WS_WGUE = 36 * MiB;
constexpr size_t WS_XB8 = 92 * MiB;
constexpr size_t WS_Y2 = 36 * MiB;
constexpr size_t WS_Y1 = 68 * MiB;
constexpr size_t WS_WDE = 148 * MiB;
constexpr size_t WS_BIG = 204 * MiB;
constexpr size_t WS_HM = WS_BIG;
constexpr size_t WS_QKV = WS_BIG;
constexpr size_t WS_H0 = WS_BIG;
constexpr size_t WS_AO = WS_BIG + 96 * MiB;
constexpr size_t WS_WIN = WS_BIG + 128 * MiB;
constexpr size_t WS_WOUT0 = WS_WIN + 4608 * 1024;
constexpr size_t WS_WGU0 = WS_WOUT0 + 2 * MiB;
constexpr size_t WS_WD0 = WS_WGU0 + 11 * MiB;
constexpr size_t WS_WQKV1 = WS_WD0 + 5632 * 1024;
constexpr size_t WS_WOUT1 = WS_WQKV1 + 6 * MiB;
constexpr size_t WS_PA1 = WS_WOUT1 + 2 * MiB;
constexpr size_t WS_PA4 = WS_PA1 + 16 * MiB;
constexpr size_t WS_LSE = WS_PA4 + 16 * MiB;
constexpr size_t WS_Y2X = WS_BIG + 238 * MiB;
constexpr size_t WS_END = WS_Y2X + 9 * 256 * 2048;
static_assert(WS_LSE + 2 * (size_t)M * 8 * 4 <= WS_END, "d_ws map");
static_assert((size_t)MAXT * 256 * FFE * 2 <= 238 * MiB, "HM fits");
constexpr int CW_CNT = 64;
constexpr int CW_CA = 1024;
constexpr int CW_BAR = 4096;

constexpr int RING_BYTES = 147456;
constexpr int EPI_OFF = 131072;
constexpr int RPB_OFF = 147456;
constexpr int MISC_OFF = 151552;
constexpr int ULIST_OFF = MISC_OFF + 256;
constexpr int OSTAGE_OFF = ULIST_OFF + 512;
constexpr int RS_OFF = OSTAGE_OFF + 8192;
constexpr int GN_OFF = RS_OFF + 2048;
constexpr int LDS_BYTES = GN_OFF + 1024;

__device__ __forceinline__ unsigned f2bf(float f) { unsigned u = __builtin_bit_cast(unsigned, f); return (u + 0x7fffu + ((u >> 16) & 1u)) >> 16; }
__device__ __forceinline__ unsigned pk2(float lo, float hi) { return f2bf(lo) | (f2bf(hi) << 16); }
__device__ __forceinline__ unsigned cvt_pk_bf16(float lo, float hi) { unsigned r; asm volatile("v_cvt_pk_bf16_f32 %0, %1, %2" : "=v"(r) : "v"(lo), "v"(hi)); return r; }
__device__ __forceinline__ float bf_lo(unsigned w) { return __builtin_bit_cast(float, w << 16); }
__device__ __forceinline__ float bf_hi(unsigned w) { return __builtin_bit_cast(float, w & 0xffff0000u); }
__device__ __forceinline__ float wave_sum(float v) {
#pragma unroll
    for (int o = 1; o < 64; o <<= 1) v += __shfl_xor(v, o);
    return v;
}
__device__ __forceinline__ float xor16_sum(float v) { float a = v, b = v; asm volatile("s_nop 1\n\tv_permlane16_swap_b32 %0, %1\n\ts_nop 1" : "+v"(a), "+v"(b)); return a + b; }
__device__ __forceinline__ float xor32_sum(float v) { float a = v, b = v; asm volatile("s_nop 1\n\tv_permlane32_swap_b32 %0, %1\n\ts_nop 1" : "+v"(a), "+v"(b)); return a + b; }
__device__ __forceinline__ float rstd_of(const float* ss, int row) { const f32x4 v = *(const f32x4*)(ss + (size_t)row * 4); return rsqrtf(((v.x + v.y) + (v.z + v.w)) * (1.0f / D) + EPS); }
namespace pg8 {
constexpr int BM = 256, BK = 64, HALF = 128, HTB = HALF * BK * 2  , STAGE_BYTES = 8 * HTB, NXCD = 8, WGM = 8;
__host__ __device__ __forceinline__ int lds_byte(int r, int c) { const int st = (r >> 4) * 2 + (c >> 5), rr = r & 15, cc = c & 31, ob = rr * 64 + cc * 2; return st * 1024 + (ob ^ (((ob >> 9) & 1) << 5)); }
__host__ __device__ __forceinline__ void stage_rc(int b, int& R, int& C) { const int st = b / 1024, sb = b % 1024, swz = sb ^ (((sb >> 9) & 1) << 5); R = (st >> 1) * 16 + swz / 64; C = (st & 1) * 32 + (swz % 64) / 2; }
__host__ __device__ __forceinline__ int gray4(int g) { return g ^ (g >> 1); }
__host__ __device__ __forceinline__ int lds_byte8(int r, int c) { const int st = (r >> 4) * 2 + (c >> 5), rr = r & 15, ch = (c >> 3) & 3; return st * 1024 + rr * 64 + ((ch ^ gray4(rr >> 2)) << 4); }
__host__ __device__ __forceinline__ void stage_rc8(int b, int& R, int& C) { const int st = b / 1024, sb = b % 1024, rr = sb / 64, ch = ((sb % 64) / 16) ^ gray4(rr >> 2); R = (st >> 1) * 16 + rr; C = (st & 1) * 32 + ch * 8; }
__host__ __device__ __forceinline__ int perm32(int rho) { const int n = rho >> 4, i = rho & 15; return 8 * (i >> 2) + 4 * n + (i & 3); }

struct Unit { int pm, pn, e, lt, aux, li; };
struct Gemm { const bf16_t* A; const bf16_t* Bt; int K; };

__device__ __forceinline__ void map_unit(int L, int nM, int nN, int nwg, int& pm, int& pn) {
    int wgid = L; { const int q = nwg / NXCD, r = nwg % NXCD, xcd = wgid % NXCD, off = wgid / NXCD; wgid = (xcd < r ? xcd * (q + 1) : r * (q + 1) + (xcd - r) * q) + off; }
    const int nig = WGM * nN, gid = wgid / nig, fm = gid * WGM, gsz = (nM - fm) < WGM ? (nM - fm) : WGM;
    pm = fm + ((wgid % nig) % gsz); pn = (wgid % nig) / gsz;
}
struct DenseOrder {
    int nM, nN, nwg, G, c, K;
    __device__ __forceinline__ void init(int M_, int N_, int K_, int G_, int c_) { nM = M_ / BM; nN = N_ / BM; nwg = nM * nN; G = G_; c = c_; K = K_; }
    __device__ __forceinline__ bool next(int i, Unit& u) const { const long L = (long)i * G + c; if (L >= nwg) return false; map_unit((int)L, nM, nN, nwg, u.pm, u.pn); u.e = 0; u.lt = 0; u.aux = -1; u.li = i; return true; }
    __device__ __forceinline__ unsigned arow(const Unit& u, int r) const { return (unsigned)(u.pm * BM + r); }
    __device__ __forceinline__ size_t boff(const Unit& u) const { return (size_t)u.pn * BM * K * 2; }
};
template <int KIND>
__device__ __forceinline__ void moe_build_list(volatile LAS unsigned* UL, const volatile LAS int* T, int nN, int G, int c, int fast, int tid, const unsigned* rowtok, LAS unsigned* TOKL) {
    if (tid < 64) {
        const int i = tid; int e = 0, lt = 0, pn = 0, aux = -1; bool ok = true;
        const bool all = (KIND == 2 || KIND == 4) && !fast;
        if (all) { const int NT = T[16]; const long L = (long)i * G + c; const int nwg = NT * nN; ok = L < nwg;
            if (ok) { int vt; map_unit((int)L, NT, nN, nwg, vt, pn); int ee = 0; for (int k = 1; k < 8; ++k) ee += (vt >= T[8 + k]) ? 1 : 0; e = ee; lt = vt - T[8 + ee]; } }
        else if (KIND == 3) { ok = i == 0; const int w = T[28 + (c >> 2)]; e = w >> 8; lt = w & 255; pn = c & 3; aux = c >> 2; }
        else {
            long q; const int X = T[17], R = T[27]; int ncol = nN;
            if (KIND == 4) { q = (long)i * G + c; }
            else {
                long L;
                if (KIND == 1) { ok = i == 0; L = c; }
                else { const int NO = 4 * X; const int s = (c < NO) ? i + 5 : i + 1; L = (s <= 4) ? (long)G + (long)(s - 1) * (G - NO) + (c - NO) : (long)G + 4L * (G - NO) + (long)(s - 5) * G + c; }
                const int nx = ncol * X;
                if (L < nx) { const int k = (int)L / ncol; const int w = T[28 + k]; e = w >> 8; lt = w & 255; pn = (int)L % ncol; aux = k; q = -1; }
                else q = L - nx;
            }
            if (q >= 0) { const int nwg = ncol * R; ok = ok && q < nwg;
                if (ok) { int r; map_unit((int)q, R, ncol, nwg, r, pn); int ee = 0; for (int k = 1; k < 8; ++k) ee += (r >= T[19 + k]) ? 1 : 0; e = ee; lt = r - T[19 + ee]; } }
        }
        const int pm = T[8 + e] + lt;
        UL[2 * i] = (unsigned)pm | ((unsigned)pn << 16);
        UL[2 * i + 1] = (unsigned)e | ((unsigned)lt << 8) | ((unsigned)(aux + 1) << 16) | (ok ? 0x80000000u : 0u);
    }
    __syncthreads();
    if (rowtok) {
        unsigned tokv[8];
#pragma unroll
        for (int k = 0; k < 8; ++k) { const int idx = tid + 512 * k, i = idx >> 8, r = idx & 255; const unsigned w1 = UL[2 * i + 1]; tokv[k] = 0u;
            if (w1 >> 31) { const int e = (int)(w1 & 255u), p = (int)((w1 >> 8) & 255u) * BM + r; if (p < T[e]) tokv[k] = rowtok[(size_t)e * CAP + p] & 0x7fffffffu; } }
#pragma unroll
        for (int k = 0; k < 8; ++k) TOKL[tid + 512 * k] = tokv[k];
        __syncthreads();
    }
}
struct ListOrder {
    int K, Nexp, gather; const volatile LAS unsigned* UL; const volatile LAS int* T; const unsigned* rowtok; const LAS unsigned* TOKL;
    __device__ __forceinline__ void init(const volatile LAS unsigned* UL_, const volatile LAS int* T_, int N_, int K_, int gather_, const unsigned* rowtok_, const LAS unsigned* TOKL_) { UL = UL_; T = T_; K = K_; Nexp = N_; gather = gather_; rowtok = rowtok_; TOKL = TOKL_; }
    __device__ __forceinline__ bool next(int i, Unit& u) const {
        const int ii = i < 63 ? i : 63; const unsigned w0 = UL[2 * ii], w1 = UL[2 * ii + 1];
        u.pm = (int)(w0 & 0xffffu); u.pn = (int)(w0 >> 16); u.e = (int)(w1 & 255u); u.lt = (int)((w1 >> 8) & 255u); u.aux = (int)((w1 >> 16) & 255u) - 1; u.li = i;
        return i < 64 && (w1 >> 31) != 0u; }
    __device__ __forceinline__ unsigned arow(const Unit& u, int r) const {
        if (!gather) return (unsigned)(u.pm * BM + r);
        if (u.li < 16) return TOKL[u.li * BM + r];
        const int idx = u.lt * BM + r; const int cnt = T[u.e];
        return idx < cnt ? (rowtok[(size_t)u.e * CAP + idx] & 0x7fffffffu) : 0u; }
    __device__ __forceinline__ size_t boff(const Unit& u) const { return ((size_t)u.e * Nexp + (size_t)u.pn * BM) * K * 2; }
};

typedef int i32x8 __attribute__((ext_vector_type(8)));
typedef int i32x4 __attribute__((ext_vector_type(4)));
#define pg8_cat(lo, hi) __builtin_shufflevector(lo, hi, 0, 1, 2, 3, 4, 5, 6, 7)
typedef f32x16 AccT[2][2][2];
#define PG8_AG(A_, ai, bj, m, n) ((f32x4){A_[ai][bj][(m) >> 1][(((m) & 1) * 2 + (n)) * 4 + 0], A_[ai][bj][(m) >> 1][(((m) & 1) * 2 + (n)) * 4 + 1], A_[ai][bj][(m) >> 1][(((m) & 1) * 2 + (n)) * 4 + 2], A_[ai][bj][(m) >> 1][(((m) & 1) * 2 + (n)) * 4 + 3]})
#define PG8_AS(A_, ai, bj, m, n, v_) do { A_[ai][bj][(m) >> 1][(((m) & 1) * 2 + (n)) * 4 + 0] = (v_)[0]; A_[ai][bj][(m) >> 1][(((m) & 1) * 2 + (n)) * 4 + 1] = (v_)[1]; A_[ai][bj][(m) >> 1][(((m) & 1) * 2 + (n)) * 4 + 2] = (v_)[2]; A_[ai][bj][(m) >> 1][(((m) & 1) * 2 + (n)) * 4 + 3] = (v_)[3]; } while (0)
template <class Epi, class Sched>
__device__ __forceinline__ void gemm_phase(LAS unsigned char* lds, const Gemm g, const Sched& S, const Epi& E) {
    int tid_ = threadIdx.x; asm volatile("" : "+v"(tid_));
    const int tid = tid_, wid = __builtin_amdgcn_readfirstlane(tid >> 6), lane = tid & 63, wr = wid >> 2, wc = wid & 3, fr = lane & 15, fq = lane >> 4;
    const int K = g.K, nt = K / BK;
    unsigned voffB0; unsigned ca0;
    { int R, C; if (Epi::FP8) stage_rc8(tid * 16, R, C); else stage_rc(tid * 16, R, C);
      const int Rb = Epi::BMODE == 0 ? R : (Epi::BMODE == 1 ? ((R & ~31) + perm32(R & 31)) : (64 * (R >> 5) + perm32(R & 31)));
      voffB0 = (unsigned)(Rb * K + C) * 2u; ca0 = (unsigned)C * 2u; }
    const unsigned dB1 = (unsigned)((Epi::BMODE == 2 ? 128 : 64) * K) * 2u;
    const size_t kstep = (size_t)(BK * 2);
    const size_t hstepB = (size_t)(Epi::BMODE == 2 ? 32 : HALF) * K * 2;
    const unsigned rowb = (unsigned)K * 2u;
    const unsigned ldsw = (unsigned)wid * 1024u;
    const int aoff = Epi::FP8 ? lds_byte8(wr * 64 + fr, fq * 16) : lds_byte(wr * 64 + fr, fq * 8), boff = Epi::FP8 ? lds_byte8(wc * 32 + fr, fq * 16) : lds_byte(wc * 32 + fr, fq * 8);
    const char* const Ab = (const char*)g.A;
#define PG8_SA(b, h) (((b) * 2 + (h)) * HTB)
#define PG8_SB(b, h) ((4 + (b) * 2 + (h)) * HTB)
#define PG8_STG(bufoff, p0, p1, aux) do { \
        __builtin_amdgcn_global_load_lds((const unsigned*)(p0), (LAS unsigned*)(lds + (bufoff) + ldsw), 16, 0, aux); \
        __builtin_amdgcn_global_load_lds((const unsigned*)(p1), (LAS unsigned*)(lds + (bufoff) + ldsw + 8192), 16, 0, aux); } while (0)
#define PG8_STAGEB(bufoff, gbase) PG8_STG(bufoff, (const char*)(gbase) + voffB0, (const char*)(gbase) + voffB0 + dB1, 0)
#define PG8_STAGEA(bufoff, kb, rp) PG8_STG(bufoff, Ab + (kb) + (((rp) & 0xffffu) * rowb + ca0), Ab + (kb) + (((rp) >> 16) * rowb + ca0), Epi::A_AUX)
#define PG8_LDA(dst, b, h) do { if constexpr (Epi::FP8) { _Pragma("unroll") for (int m = 0; m < 4; ++m) dst##8[m] = pg8_cat(*(const LAS i32x4*)(lds + PG8_SA(b, h) + aoff + m * 2048), *(const LAS i32x4*)(lds + PG8_SA(b, h) + (aoff ^ 16) + m * 2048)); } \
        else { _Pragma("unroll") for (int m = 0; m < 4; ++m) _Pragma("unroll") for (int k = 0; k < 2; ++k) dst[m][k] = *(const LAS i32x4*)(lds + PG8_SA(b, h) + aoff + m * 2048 + k * 1024); } } while (0)
#define PG8_LDB(dst, b, h) do { if constexpr (Epi::FP8) { _Pragma("unroll") for (int n = 0; n < 2; ++n) dst##8[n] = pg8_cat(*(const LAS i32x4*)(lds + PG8_SB(b, h) + boff + n * 2048), *(const LAS i32x4*)(lds + PG8_SB(b, h) + (boff ^ 16) + n * 2048)); } \
        else { _Pragma("unroll") for (int n = 0; n < 2; ++n) _Pragma("unroll") for (int k = 0; k < 2; ++k) dst[n][k] = *(const LAS i32x4*)(lds + PG8_SB(b, h) + boff + n * 2048 + k * 1024); } } while (0)
#define PG8_MMA(ai, bj, At, Bt) do { __builtin_amdgcn_s_setprio(1); \
        if constexpr (Epi::FP8) { _Pragma("unroll") for (int m = 0; m < 4; ++m) _Pragma("unroll") for (int n = 0; n < 2; ++n) \
            { const f32x4 r_ = __builtin_amdgcn_mfma_scale_f32_16x16x128_f8f6f4(Bt##8[n], At##8[m], PG8_AG(acc, ai, bj, m, n), 0, 0, 0, 127, 0, 127); PG8_AS(acc, ai, bj, m, n, r_); } } \
        else { _Pragma("unroll") for (int m = 0; m < 4; ++m) _Pragma("unroll") for (int n = 0; n < 2; ++n) _Pragma("unroll") for (int k = 0; k < 2; ++k) \
            { const f32x4 r_ = __builtin_amdgcn_mfma_f32_16x16x32_bf16(__builtin_bit_cast(bf16x8, Bt[n][k]), __builtin_bit_cast(bf16x8, At[m][k]), PG8_AG(acc, ai, bj, m, n), 0, 0, 0); PG8_AS(acc, ai, bj, m, n, r_); } } \
        __builtin_amdgcn_s_setprio(0); } while (0)
#define PG8_WAIT_V(n) asm volatile("s_waitcnt vmcnt(" #n ")" ::: "memory")
#define PG8_WAIT_L(n) asm volatile("s_waitcnt lgkmcnt(" #n ")" ::: "memory")
#define PG8_BAR __builtin_amdgcn_s_barrier()
#define PG8_SCHED __builtin_amdgcn_sched_barrier(0)
#define PG8_ROWS(dst, u) do { int t2_ = tid; asm volatile("" : "+v"(t2_)); int R_, C_; if (Epi::FP8) stage_rc8(t2_ * 16, R_, C_); else stage_rc(t2_ * 16, R_, C_); \
        _Pragma("unroll") for (int h = 0; h < 2; ++h) dst[h] = S.arow(u, h * HALF + R_) | (S.arow(u, h * HALF + R_ + 64) << 16); } while (0)
    Unit cur, nxt; int ui = 0;
    if (!S.next(0, cur)) return;
    AccT acc;
#pragma unroll
    for (int a = 0; a < 2; ++a)
#pragma unroll
        for (int b = 0; b < 2; ++b)
#pragma unroll
            for (int m = 0; m < 2; ++m)
#pragma unroll
                for (int q = 0; q < 16; ++q) acc[a][b][m][q] = 0.f;
    i32x4 At[4][2], B0[2][2], B1[2][2]; i32x8 At8[4], B08[2], B18[2];
    unsigned rc[2], rn[2];
    PG8_ROWS(rc, cur);
    E.pre_store(E.pre_load(cur, tid), 0, lds, tid);
    const char* cB = (const char*)g.Bt + S.boff(cur);
    PG8_STAGEB(PG8_SB(0, 0), cB); PG8_STAGEB(PG8_SB(0, 1), cB + hstepB); PG8_STAGEA(PG8_SA(0, 0), 0, rc[0]); PG8_STAGEA(PG8_SA(0, 1), 0, rc[1]);
    if (wr == 1) PG8_BAR;
    PG8_WAIT_V(2); PG8_BAR;
    PG8_STAGEB(PG8_SB(1, 0), cB + kstep); PG8_STAGEA(PG8_SA(1, 0), kstep, rc[0]); PG8_STAGEB(PG8_SB(1, 1), cB + hstepB + kstep);
    PG8_WAIT_V(6); PG8_BAR;
    for (;;) {
        const bool has_next = S.next(ui + 1, nxt);
        if (has_next) { PG8_ROWS(rn, nxt); } else { rn[0] = rc[0]; rn[1] = rc[1]; }
        const char* nB = has_next ? (const char*)g.Bt + S.boff(nxt) : cB;
#pragma unroll 1
        for (int t = 0; t < nt; t += 2) {
            const bool last = (t == nt - 2);
            const size_t k1 = (size_t)(t + 1) * kstep;
            const size_t k2 = last ? (size_t)0 : (size_t)(t + 2) * kstep, k3 = k2 + kstep;
            const char* b2 = last ? nB : cB + (size_t)(t + 2) * kstep; const char* b3 = b2 + kstep;
            const unsigned ra0 = last ? rn[0] : rc[0], ra1 = last ? rn[1] : rc[1];
            PG8_LDB(B0, 0, 0); PG8_LDB(B1, 0, 1); PG8_SCHED; PG8_LDA(At, 0, 0); PG8_STAGEA(PG8_SA(1, 1), k1, rc[1]);
            PG8_WAIT_V(8); PG8_WAIT_L(0); PG8_BAR; PG8_MMA(0, 0, At, B0); PG8_MMA(0, 1, At, B1); PG8_BAR; PG8_SCHED;
            PG8_LDA(At, 0, 1); PG8_STAGEB(PG8_SB(0, 0), b2); PG8_STAGEB(PG8_SB(0, 1), b2 + hstepB); PG8_STAGEA(PG8_SA(0, 0), k2, ra0);
            PG8_WAIT_V(8); PG8_WAIT_L(0); PG8_BAR; PG8_MMA(1, 0, At, B0); PG8_MMA(1, 1, At, B1); PG8_BAR; PG8_SCHED;
            PG8_LDB(B0, 1, 0); PG8_LDB(B1, 1, 1); PG8_SCHED; PG8_LDA(At, 1, 0); PG8_STAGEA(PG8_SA(0, 1), k2, ra1);
            PG8_WAIT_V(8); PG8_WAIT_L(0); PG8_BAR; PG8_MMA(0, 0, At, B0); PG8_MMA(0, 1, At, B1); PG8_BAR; PG8_SCHED;
            PG8_LDA(At, 1, 1); PG8_STAGEB(PG8_SB(1, 0), b3); PG8_STAGEB(PG8_SB(1, 1), b3 + hstepB); PG8_STAGEA(PG8_SA(1, 0), k3, ra0);
            PG8_WAIT_V(8); PG8_WAIT_L(0); PG8_BAR; PG8_MMA(1, 0, At, B0); PG8_MMA(1, 1, At, B1); PG8_BAR; PG8_SCHED;
        }
        if (Epi::ALIGN) { if (wr == 0) PG8_BAR; }
        const float nrs = has_next ? E.pre_load(nxt, tid) : 0.f;
        E(acc, cur, wr, wc, fr, fq, lds, tid, ui & 1);
        if (!has_next) break;
        E.pre_store(nrs, (ui + 1) & 1, lds, tid);
#pragma unroll
        for (int a = 0; a < 2; ++a)
#pragma unroll
            for (int b = 0; b < 2; ++b)
#pragma unroll
                for (int m = 0; m < 2; ++m)
#pragma unroll
                    for (int q = 0; q < 16; ++q) acc[a][b][m][q] = 0.f;
        cur = nxt; cB = nB; ++ui;
        rc[0] = rn[0]; rc[1] = rn[1];
        if (Epi::ALIGN) { if (wr == 1) PG8_BAR; }
    }
    PG8_WAIT_V(0);
    if (!Epi::ALIGN) { if (wr == 0) PG8_BAR; }
    PG8_BAR;
#undef PG8_SA
#undef PG8_SB
#undef PG8_STG
#undef PG8_STAGEA
#undef PG8_STAGEB
#undef PG8_LDA
#undef PG8_LDB
#undef PG8_MMA
#undef PG8_WAIT_V
#undef PG8_WAIT_L
#undef PG8_BAR
#undef PG8_SCHED
#undef PG8_ROWS
}
}
namespace pg8 {
struct EpiQKV {
    static constexpr int BMODE = 2, A_AUX = 0; static constexpr bool ALIGN = true, FP8 = false; static constexpr int NST = 16;
    bf16_t* O; int ldc; const float* ss; int layer;
    __device__ __forceinline__ float pre_load(const Unit& u, int tid) const { return tid < 256 ? rstd_of(ss, u.pm * BM + tid) : 0.f; }
    __device__ __forceinline__ void pre_store(float v, int buf, LAS unsigned char* lds, int tid) const { if (tid < 256) ((LAS float*)(lds + RS_OFF))[buf * 256 + tid] = v; }
    __device__ __forceinline__ void operator()(const AccT& acc, const Unit& u, int wr, int wc, int fr, int fq, LAS unsigned char* lds, int, int buf) const {
        int kind = 0, gi = 0;
        if (layer == 0) {
            if (u.pn < 2) { kind = 1; gi = 0; } else if (u.pn < 4) { kind = 2; gi = 1; } else if (u.pn < 6) { kind = 0; }
            else if (u.pn < 8) { kind = 1; gi = 2; } else { if (wc < 2) { kind = 2; gi = 3; } }
        } else { if (u.pn < 4) { kind = 1; gi = 0; } else if (u.pn < 8) { kind = 2; gi = 1; } }
        const LAS float* g = (const LAS float*)(lds + GN_OFF) + gi * 64; const LAS float* RS = (const LAS float*)(lds + RS_OFF) + buf * 256;
        f32x4 gv[2][2];
#pragma unroll
        for (int bj = 0; bj < 2; ++bj)
#pragma unroll
            for (int n = 0; n < 2; ++n) gv[bj][n] = kind ? *(const LAS f32x4*)(g + 32 * bj + 8 * fq + 4 * n) : (f32x4){1.f, 1.f, 1.f, 1.f};
        const float post = kind == 1 ? C2 : 1.f;
        bf16_t* slotp = O + (size_t)(4 * u.pn + wc) * M * 64 + 8 * fq;
        float rsv[2][4];
#pragma unroll
        for (int ai = 0; ai < 2; ++ai)
#pragma unroll
            for (int m = 0; m < 4; ++m) rsv[ai][m] = RS[ai * HALF + wr * 64 + m * 16 + fr];
#pragma unroll
        for (int ai = 0; ai < 2; ++ai)
#pragma unroll
            for (int m = 0; m < 4; ++m) {
                const int row = u.pm * BM + ai * HALF + wr * 64 + m * 16 + fr;
                const float rs = rsv[ai][m];
                float sc = rs;
                if (kind) {
                    float q = 0.f;
#pragma unroll
                    for (int bj = 0; bj < 2; ++bj)
#pragma unroll
                        for (int n = 0; n < 2; ++n) { const f32x4 x = PG8_AG(acc, ai, bj, m, n); q += (x[0] * x[0] + x[1] * x[1]) + (x[2] * x[2] + x[3] * x[3]); }
                    q = xor32_sum(xor16_sum(q));
                    sc = rs * __builtin_amdgcn_rsqf(rs * rs * q * (1.0f / 64.0f) + EPS) * post;
                }
                bf16_t* rowp = slotp + (size_t)row * 64;
#pragma unroll
                for (int bj = 0; bj < 2; ++bj) { const f32x4 v0 = PG8_AG(acc, ai, bj, m, 0) * sc * gv[bj][0], v1 = PG8_AG(acc, ai, bj, m, 1) * sc * gv[bj][1];
                    u32x4 w; w.x = cvt_pk_bf16(v0[0], v0[1]); w.y = cvt_pk_bf16(v0[2], v0[3]); w.z = cvt_pk_bf16(v1[0], v1[1]); w.w = cvt_pk_bf16(v1[2], v1[3]);
                    *(u32x4*)(rowp + 32 * bj) = w; }
            }
    }
};
template <bool F8>
struct EpiSwi {
    static constexpr int BMODE = 1, A_AUX = 0; static constexpr bool ALIGN = true, FP8 = F8; static constexpr int NST = 8;
    bf16_t* H; int ldh; const float* ss; const float* rowrs; const volatile LAS int* T;
    __device__ __forceinline__ float pre_load(const Unit& u, int tid) const {
        if (tid >= 256) return 0.f;
        if (rowrs) { const int idx = u.lt * BM + tid; return idx < T[u.e] ? rowrs[(size_t)u.e * CAP + idx] : 0.f; }
        return rstd_of(ss, u.pm * BM + tid); }
    __device__ __forceinline__ void pre_store(float v, int buf, LAS unsigned char* lds, int tid) const { if (tid < 256) ((LAS float*)(lds + RS_OFF))[buf * 256 + tid] = v; }
    __device__ __forceinline__ void operator()(const AccT& acc, const Unit& u, int wr, int wc, int fr, int fq, LAS unsigned char* lds, int, int buf) const {
        const int col0 = u.pn * HALF + 32 * wc + 8 * fq;
        const LAS float* RS = (const LAS float*)(lds + RS_OFF) + buf * 256;
        float rsv[2][4];
#pragma unroll
        for (int ai = 0; ai < 2; ++ai)
#pragma unroll
            for (int m = 0; m < 4; ++m) rsv[ai][m] = RS[ai * HALF + wr * 64 + m * 16 + fr];
#pragma unroll
        for (int ai = 0; ai < 2; ++ai)
#pragma unroll
            for (int m = 0; m < 4; ++m) {
                const int r = ai * HALF + wr * 64 + m * 16 + fr; const int row = u.pm * BM + r;
                const float rs = F8 ? rsv[ai][m] * (1.0f / (W8_SCALE * X8_SCALE)) : rsv[ai][m];
                const float tn = -rs * LOG2E, ic = __builtin_amdgcn_rcpf(rs * rs * (F8 ? H8_SCALE : 1.0f));
                const f32x2 tn2 = {tn, tn}, ic2 = {ic, ic};
                float h[8];
#pragma unroll
                for (int n = 0; n < 2; ++n) { const f32x4 g4 = PG8_AG(acc, ai, 0, m, n), u4 = PG8_AG(acc, ai, 1, m, n);
#pragma unroll
                    for (int p = 0; p < 2; ++p) { const f32x2 g2 = {g4[2 * p], g4[2 * p + 1]}, u2 = {u4[2 * p], u4[2 * p + 1]};
                        const f32x2 t2 = g2 * tn2; const f32x2 e2 = {__builtin_amdgcn_exp2f(t2.x), __builtin_amdgcn_exp2f(t2.y)};
                        const f32x2 d2 = __builtin_elementwise_fma(e2, ic2, ic2); const f32x2 r2 = {__builtin_amdgcn_rcpf(d2.x), __builtin_amdgcn_rcpf(d2.y)};
                        const f32x2 h2 = (g2 * u2) * r2; h[4 * n + 2 * p] = h2.x; h[4 * n + 2 * p + 1] = h2.y; } }
                if (F8) {
                    float c8[8];
#pragma unroll
                    for (int j = 0; j < 8; ++j) c8[j] = __builtin_amdgcn_fmed3f(h[j], -448.f, 448.f);
                    int w0 = 0, w1 = 0;
                    w0 = __builtin_amdgcn_cvt_pk_fp8_f32(c8[0], c8[1], w0, false); w0 = __builtin_amdgcn_cvt_pk_fp8_f32(c8[2], c8[3], w0, true);
                    w1 = __builtin_amdgcn_cvt_pk_fp8_f32(c8[4], c8[5], w1, false); w1 = __builtin_amdgcn_cvt_pk_fp8_f32(c8[6], c8[7], w1, true);
                    u32x2 w8; w8.x = (unsigned)w0; w8.y = (unsigned)w1; *(u32x2*)((unsigned char*)H + (size_t)row * ldh + col0) = w8;
                } else {
                    u32x4 w; w.x = cvt_pk_bf16(h[0], h[1]); w.y = cvt_pk_bf16(h[2], h[3]); w.z = cvt_pk_bf16(h[4], h[5]); w.w = cvt_pk_bf16(h[6], h[7]);
                    *(u32x4*)(H + (size_t)row * ldh + col0) = w; }
            }
    }
};
struct EpiRes {
    static constexpr int BMODE = 1, A_AUX = 0; static constexpr bool ALIGN = true, FP8 = false; static constexpr int NST = 0;
    bf16_t* xb; float* ssout; bf16_t* xout;
    __device__ __forceinline__ float pre_load(const Unit&, int) const { return 0.f; }
    __device__ __forceinline__ void pre_store(float, int, LAS unsigned char*, int) const {}
    __device__ __forceinline__ void operator()(const AccT& acc, const Unit& u, int wr, int wc, int fr, int fq, LAS unsigned char* lds, int tid, int) const {
        LAS float* P = (LAS float*)(lds + EPI_OFF);
        const int col0 = u.pn * BM + wc * 32 + 8 * fq;
#pragma unroll
        for (int ai = 0; ai < 2; ++ai) {
            u32x4 bb[4][2];
#pragma unroll
            for (int m = 0; m < 4; ++m)
#pragma unroll
                for (int bj = 0; bj < 2; ++bj) bb[m][bj] = *(const u32x4*)(xb + (size_t)(u.pm * BM + ai * HALF + wr * 64 + m * 16 + fr) * D + col0 + bj * HALF);
#pragma unroll
            for (int m = 0; m < 4; ++m) {
                const int r = ai * HALF + wr * 64 + m * 16 + fr; const size_t off = (size_t)(u.pm * BM + r) * D + col0;
                float q = 0.f;
#pragma unroll
                for (int bj = 0; bj < 2; ++bj) {
                    const u32x4 b = bb[m][bj];
                    const f32x4 v0 = PG8_AG(acc, ai, bj, m, 0) + (f32x4){bf_lo(b.x), bf_hi(b.x), bf_lo(b.y), bf_hi(b.y)}, v1 = PG8_AG(acc, ai, bj, m, 1) + (f32x4){bf_lo(b.z), bf_hi(b.z), bf_lo(b.w), bf_hi(b.w)};
                    u32x4 w; w.x = cvt_pk_bf16(v0[0], v0[1]); w.y = cvt_pk_bf16(v0[2], v0[3]); w.z = cvt_pk_bf16(v1[0], v1[1]); w.w = cvt_pk_bf16(v1[2], v1[3]);
                    *(u32x4*)(xout + off + bj * HALF) = w;
                    q += (v0[0] * v0[0] + v0[1] * v0[1]) + (v0[2] * v0[2] + v0[3] * v0[3]) + (v1[0] * v1[0] + v1[1] * v1[1]) + (v1[2] * v1[2] + v1[3] * v1[3]); }
                q = xor32_sum(xor16_sum(q));
                if (fq == 0) P[r * 4 + wc] = q;
            }
        }
        LDS_WAIT(); __builtin_amdgcn_s_barrier(); asm volatile("" ::: "memory");
        if (tid < 256) { const f32x4 p = *(const LAS f32x4*)(P + tid * 4); ssout[(size_t)(u.pm * BM + tid) * 4 + u.pn] = (p.x + p.y) + (p.z + p.w); }
        LDS_WAIT();
    }
};
struct EpiMoeDown {
    static constexpr int BMODE = 1, A_AUX = 0; static constexpr bool ALIGN = true, FP8 = true; static constexpr int NST = 0;
    bf16_t* y1; bf16_t* y2; bf16_t* yx; const unsigned* rowtok; const float* rowgate; const volatile LAS int* T;
    __device__ __forceinline__ float pre_load(const Unit&, int) const { return 0.f; }
    __device__ __forceinline__ void pre_store(float, int, LAS unsigned char*, int) const {}
    __device__ __forceinline__ void operator()(const AccT& acc, const Unit& u, int wr, int wc, int fr, int fq, LAS unsigned char*, int, int) const {
        const int col0 = u.pn * BM + wc * 32 + 8 * fq; const int cnt = T[u.e];
        unsigned tkv[2][4]; float gtv[2][4];
#pragma unroll
        for (int ai = 0; ai < 2; ++ai)
#pragma unroll
            for (int m = 0; m < 4; ++m) { const int idx = u.lt * BM + ai * HALF + wr * 64 + m * 16 + fr; const bool ok = idx < cnt;
                tkv[ai][m] = ok ? rowtok[(size_t)u.e * CAP + idx] : 0u; gtv[ai][m] = ok ? rowgate[(size_t)u.e * CAP + idx] * (1.0f / (H8_SCALE * W8_SCALE)) : 0.f; }
#pragma unroll
        for (int ai = 0; ai < 2; ++ai)
#pragma unroll
            for (int m = 0; m < 4; ++m) {
                const int r = ai * HALF + wr * 64 + m * 16 + fr; const int idx = u.lt * BM + r;
                if (idx < cnt) {
                    const unsigned tk = tkv[ai][m]; const float gt = gtv[ai][m];
                    bf16_t* dst = u.aux >= 0 ? yx + (size_t)(u.aux * BM + r) * D + col0 : ((tk >> 31) ? y2 : y1) + (size_t)(tk & 0x7fffffffu) * D + col0;
#pragma unroll
                    for (int bj = 0; bj < 2; ++bj) { const f32x4 v0 = PG8_AG(acc, ai, bj, m, 0) * gt, v1 = PG8_AG(acc, ai, bj, m, 1) * gt;
                        u32x4 w; w.x = cvt_pk_bf16(v0[0], v0[1]); w.y = cvt_pk_bf16(v0[2], v0[3]); w.z = cvt_pk_bf16(v1[0], v1[1]); w.w = cvt_pk_bf16(v1[2], v1[3]);
                        *(u32x4*)(dst + bj * HALF) = w; }
                }
            }
    }
};
}
#define XB_TMO      128
#define XB_XCNT(j)  (256  + 64 * (j))
#define XB_XSUB(j)  (1280 + 64 * (j))
#define XB_XGEN(j)  (2304 + 64 * (j))
#define XB_TOP      3328
#define XB_TOPGEN   3392
#define XCD_BAR_WORDS 3456
#define XB_SPIN_CAP (1u << 18)

__device__ __forceinline__ unsigned xb_ld(unsigned* p)              { return __hip_atomic_load(p, __ATOMIC_RELAXED, __HIP_MEMORY_SCOPE_AGENT); }
__device__ __forceinline__ unsigned xb_add(unsigned* p, unsigned v) { return __hip_atomic_fetch_add(p, v, __ATOMIC_RELAXED, __HIP_MEMORY_SCOPE_AGENT); }
__device__ __forceinline__ unsigned xb_xcc_id() { return (unsigned)__builtin_amdgcn_s_getreg((3 << 11) | 20) & 0xFu; }
#define XB_SPIN(cond, bar) do { unsigned _sp = 0; while (cond) { __builtin_amdgcn_s_sleep(1); \
    if ((++_sp & 255u) == 0u) { if (xb_ld(&(bar)[XB_TMO])) break; if (_sp > XB_SPIN_CAP) { atomicAdd(&(bar)[XB_TMO], 1u); break; } } } } while (0)

struct XcdBarrier {
    unsigned* bar; unsigned x;
    volatile LAS unsigned* st;
};

__device__ __forceinline__ XcdBarrier xcd_barrier_post(unsigned* bar, volatile LAS unsigned* st) {
    XcdBarrier b; b.bar = bar; b.x = xb_xcc_id(); b.st = st;
    if (threadIdx.x == 0) (void)xb_add(&bar[XB_XCNT(b.x)], 1u);
    return b;
}
__device__ __forceinline__ void xcd_barrier_complete(unsigned* bar, unsigned x, unsigned& nloc, unsigned& nx) {
    const unsigned G = gridDim.x * gridDim.y * gridDim.z;
    unsigned sum, cnt, mine, sp = 0u;
    for (;;) {
        sum = 0u; cnt = 0u; mine = 0u;
#pragma unroll
        for (unsigned j = 0; j < 16; ++j) { const unsigned c = xb_ld(&bar[XB_XCNT(j)]); sum += c; cnt += (c > 0u) ? 1u : 0u; mine = (j == x) ? c : mine; }
        if (sum == G) break;
        __builtin_amdgcn_s_sleep(1);
        if ((++sp & 255u) == 0u) { if (xb_ld(&bar[XB_TMO])) break; if (sp > XB_SPIN_CAP) { atomicAdd(&bar[XB_TMO], 1u); break; } }
    }
    nloc = mine > 0u ? mine : 1u; nx = cnt > 0u ? cnt : 1u;
}

__device__ __forceinline__ void xcd_barrier(const XcdBarrier& b) {
    asm volatile("s_waitcnt vmcnt(0)" ::: "memory");
    __syncthreads();
    if (threadIdx.x == 0) {
        unsigned* bar = b.bar;
        __builtin_amdgcn_s_waitcnt(0);
        unsigned nloc = b.st[0], nx = b.st[1];
        if (nloc == 0u) { xcd_barrier_complete(bar, b.x, nloc, nx); b.st[0] = nloc; b.st[1] = nx; }
        const unsigned old = xb_add(&bar[XB_XSUB(b.x)], 1u);
        const unsigned gen = old / nloc;
        if (old + 1u == (gen + 1u) * nloc) {
            __builtin_amdgcn_fence(__ATOMIC_RELEASE, "agent");
            asm volatile("s_waitcnt vmcnt(0)" ::: "memory");
            const unsigned og = xb_add(&bar[XB_TOP], 1u);
            const unsigned tg = og / nx;
            if (og + 1u == (tg + 1u) * nx) xb_add(&bar[XB_TOPGEN], 1u);
            else XB_SPIN(xb_ld(&bar[XB_TOPGEN]) == tg, bar);
            __builtin_amdgcn_fence(__ATOMIC_ACQUIRE, "agent");
            xb_add(&bar[XB_XGEN(b.x)], 1u);
            asm volatile("s_waitcnt vmcnt(0)" ::: "memory");
        } else {
            XB_SPIN(xb_ld(&bar[XB_XGEN(b.x)]) == gen, bar);
            __builtin_amdgcn_fence(__ATOMIC_ACQUIRE, "agent");
            asm volatile("s_waitcnt vmcnt(0)" ::: "memory");
        }
    }
    __syncthreads();
}
namespace att {
constexpr int TILE_B = 8192;
__device__ __forceinline__ void glds16(const void* g, LAS unsigned char* l) { __builtin_amdgcn_global_load_lds((const unsigned*)g, (LAS unsigned*)l, 16, 0, 0); }
__device__ __forceinline__ s16x4 vtr(const LAS unsigned char* p) { typedef short v4i16_t __attribute__((ext_vector_type(4))); return __builtin_bit_cast(s16x4, __builtin_amdgcn_ds_read_tr16_b64_v4i16((LAS v4i16_t*)p)); }

__device__ __forceinline__ void stage_tile(LAS unsigned char* kt, LAS unsigned char* vt, const bf16_t* Kg, const bf16_t* Vg, int pitch, int ktok, int vtok, int wid, int lane) {
    const int c = (lane & 7) ^ ((4 * wid + (lane >> 4)) & 7);
    glds16(Kg + (size_t)ktok * pitch + c * 8, kt + wid * 1024);
    glds16(Vg + (size_t)vtok * pitch + (wid >> 2) * 32 + (lane & 3) * 8, vt + wid * 1024);
}
__device__ __forceinline__ void fetch_tile(u32x4& kreg, u32x4& vreg, const bf16_t* Kg, const bf16_t* Vg, int pitch, int ktok, int vtok, int wid, int lane) {
    const int c = (lane & 7) ^ ((4 * wid + (lane >> 4)) & 7);
    kreg = *(const u32x4*)(Kg + (size_t)ktok * pitch + c * 8);
    vreg = *(const u32x4*)(Vg + (size_t)vtok * pitch + (wid >> 2) * 32 + (lane & 3) * 8);
}
__device__ __forceinline__ void commit_tile(LAS unsigned char* kt, LAS unsigned char* vt, const u32x4& kreg, const u32x4& vreg, int wid, int lane) {
    *(LAS u32x4*)(kt + wid * 1024 + lane * 16) = kreg; *(LAS u32x4*)(vt + wid * 1024 + lane * 16) = vreg;
}
__device__ __forceinline__ int crow(int r) { return (r & 3) + 8 * (r >> 2); }

template <class CI, class PM>
__device__ __forceinline__ void half_step(const LAS unsigned char* kaddr, const unsigned (&so)[4], const LAS unsigned char* vb, const unsigned (&vo)[4], const bf16x8 (&qr)[4], f32x16 (&o)[2], float& lrun, const CI& ci, const PM& pm) {
    f32x16 p;
#pragma unroll
    for (int r = 0; r < 16; ++r) p[r] = ci(crow(r));
#pragma unroll
    for (int d0 = 0; d0 < 4; ++d0) p = __builtin_amdgcn_mfma_f32_32x32x16_bf16(*(const LAS bf16x8*)(kaddr + so[d0]), qr[d0], p, 0, 0, 0);
    float rs = 0.f;
#pragma unroll
    for (int r = 0; r < 16; ++r) { p[r] = __builtin_amdgcn_exp2f(pm(p[r], crow(r))); rs += p[r]; }
    lrun += rs;
    u32x4 pw0, pw1;
#pragma unroll
    for (int j = 0; j < 4; ++j) { pw0[j] = cvt_pk_bf16(p[2 * j], p[2 * j + 1]); pw1[j] = cvt_pk_bf16(p[8 + 2 * j], p[9 + 2 * j]); }
#pragma unroll
    for (int d0 = 0; d0 < 2; ++d0) {
        const s16x4 a0 = vtr(vb + vo[0] + d0 * 4096), a1 = vtr(vb + vo[1] + d0 * 4096), b0 = vtr(vb + vo[2] + d0 * 4096), b1 = vtr(vb + vo[3] + d0 * 4096);
        o[d0] = __builtin_amdgcn_mfma_f32_32x32x16_bf16((bf16x8){a0[0], a0[1], a0[2], a0[3], a1[0], a1[1], a1[2], a1[3]}, __builtin_bit_cast(bf16x8, pw0), o[d0], 0, 0, 0);
        o[d0] = __builtin_amdgcn_mfma_f32_32x32x16_bf16((bf16x8){b0[0], b0[1], b0[2], b0[3], b1[0], b1[1], b1[2], b1[3]}, __builtin_bit_cast(bf16x8, pw1), o[d0], 0, 0, 0);
    }
}
__device__ __forceinline__ void store_o(bf16_t* orow, const f32x16 (&o)[2], float inv, int hi) {
#pragma unroll
    for (int d0 = 0; d0 < 2; ++d0)
#pragma unroll
        for (int gq = 0; gq < 4; ++gq) { u32x2 w; w.x = cvt_pk_bf16(o[d0][4 * gq] * inv, o[d0][4 * gq + 1] * inv); w.y = cvt_pk_bf16(o[d0][4 * gq + 2] * inv, o[d0][4 * gq + 3] * inv);
            *(u32x2*)(orow + 32 * d0 + 8 * gq + 4 * hi) = w; }
}
template <bool FULL>
__device__ __forceinline__ void stage_o(LAS unsigned char* stg, const f32x16 (&o)[2], float inv, int r32, int hi) {
#pragma unroll
    for (int d0 = 0; d0 < 2; ++d0)
#pragma unroll
        for (int gq = 0; gq < 4; ++gq) { u32x2 w; w.x = cvt_pk_bf16(o[d0][4 * gq] * inv, o[d0][4 * gq + 1] * inv); w.y = cvt_pk_bf16(o[d0][4 * gq + 2] * inv, o[d0][4 * gq + 3] * inv);
            if (FULL) *(LAS u32x2*)(stg + r32 * 128 + (32 * d0 + 8 * gq + 4 * hi) * 2) = w; else *(LAS u32x2*)(stg + d0 * 2048 + r32 * 64 + (8 * gq + 4 * hi) * 2) = w; }
}
template <bool FULL, class RP>
__device__ __forceinline__ void flush_o(const LAS unsigned char* stg, int lane, const RP& rowptr) {
    if (FULL) {
#pragma unroll
        for (int i = 0; i < 4; ++i) { const int row = i * 8 + (lane >> 3), ch = lane & 7; const u32x4 v = *(const LAS u32x4*)(stg + row * 128 + ch * 16); *(u32x4*)(rowptr(row) + ch * 8) = v; }
    } else {
#pragma unroll
        for (int d0 = 0; d0 < 2; ++d0)
#pragma unroll
            for (int i = 0; i < 2; ++i) { const int row = i * 16 + (lane >> 2), ch = lane & 3; const u32x4 v = *(const LAS u32x4*)(stg + d0 * 2048 + row * 64 + ch * 16); *(u32x4*)(rowptr(row) + 32 * d0 + ch * 8) = v; }
    }
}
struct HS { const LAS unsigned char* ka; const LAS unsigned char* vb; const LAS float* tb; };
template <int NT, class HSF>
__device__ __forceinline__ void pipe_rows(const HSF& hsf, const unsigned (&so)[4], const unsigned (&vo)[4], const bf16x8 (&qr)[4], f32x16 (&o)[2], float& lrun, const int wm) {
#define ATT_SB() __builtin_amdgcn_sched_barrier(0)
#define ATT_E(r) do { const float x_ = __builtin_amdgcn_exp2f(pc[r]); pc[r] = __builtin_bit_cast(float, __builtin_bit_cast(unsigned, x_) & (unsigned)__builtin_amdgcn_sbfe(wm, crow(r), 1)); rs += pc[r]; } while (0)
#define ATT_KF(d0) (*(const LAS bf16x8*)(hn.ka + so[d0]))
#define ATT_V8(a_, b_) ((bf16x8){a_[0], a_[1], a_[2], a_[3], b_[0], b_[1], b_[2], b_[3]})
    f32x16 pc;
    { const HS h = hsf(0);
#pragma unroll
      for (int r = 0; r < 16; ++r) pc[r] = h.tb[crow(r)];
#pragma unroll
      for (int d0 = 0; d0 < 4; ++d0) pc = __builtin_amdgcn_mfma_f32_32x32x16_bf16(*(const LAS bf16x8*)(h.ka + so[d0]), qr[d0], pc, 0, 0, 0); }
#pragma unroll
    for (int t = 0; t < NT; ++t) {
        const bool more = t + 1 < NT;
        const HS h = hsf(t); const HS hn = hsf(more ? t + 1 : t);
        f32x16 pn; bf16x8 k0, k1; float rs = 0.f;
        if (more) {
#pragma unroll
            for (int r = 0; r < 16; ++r) pn[r] = hn.tb[crow(r)];
            k0 = ATT_KF(0); k1 = ATT_KF(1);
        }
        const s16x4 a00 = vtr(h.vb + vo[0]), a01 = vtr(h.vb + vo[1]), a10 = vtr(h.vb + vo[0] + 4096), a11 = vtr(h.vb + vo[1] + 4096);
        ATT_SB();
        if (more) pn = __builtin_amdgcn_mfma_f32_32x32x16_bf16(k0, qr[0], pn, 0, 0, 0);
        if (more) k0 = ATT_KF(2);
        ATT_E(0); ATT_E(1); ATT_E(2); ATT_E(3);
        ATT_SB();
        if (more) pn = __builtin_amdgcn_mfma_f32_32x32x16_bf16(k1, qr[1], pn, 0, 0, 0);
        if (more) k1 = ATT_KF(3);
        const s16x4 b00 = vtr(h.vb + vo[2]), b01 = vtr(h.vb + vo[3]), b10 = vtr(h.vb + vo[2] + 4096), b11 = vtr(h.vb + vo[3] + 4096);
        ATT_E(4); ATT_E(5); ATT_E(6); ATT_E(7);
        u32x4 pw0, pw1;
#pragma unroll
        for (int j = 0; j < 4; ++j) pw0[j] = cvt_pk_bf16(pc[2 * j], pc[2 * j + 1]);
        ATT_SB();
        if (more) pn = __builtin_amdgcn_mfma_f32_32x32x16_bf16(k0, qr[2], pn, 0, 0, 0);
        o[0] = __builtin_amdgcn_mfma_f32_32x32x16_bf16(ATT_V8(a00, a01), __builtin_bit_cast(bf16x8, pw0), o[0], 0, 0, 0);
        ATT_E(8); ATT_E(9); ATT_E(10); ATT_E(11);
        ATT_SB();
        if (more) pn = __builtin_amdgcn_mfma_f32_32x32x16_bf16(k1, qr[3], pn, 0, 0, 0);
        o[1] = __builtin_amdgcn_mfma_f32_32x32x16_bf16(ATT_V8(a10, a11), __builtin_bit_cast(bf16x8, pw0), o[1], 0, 0, 0);
        ATT_E(12); ATT_E(13); ATT_E(14); ATT_E(15);
#pragma unroll
        for (int j = 0; j < 4; ++j) pw1[j] = cvt_pk_bf16(pc[8 + 2 * j], pc[9 + 2 * j]);
        lrun += rs;
        ATT_SB();
        o[0] = __builtin_amdgcn_mfma_f32_32x32x16_bf16(ATT_V8(b00, b01), __builtin_bit_cast(bf16x8, pw1), o[0], 0, 0, 0);
        o[1] = __builtin_amdgcn_mfma_f32_32x32x16_bf16(ATT_V8(b10, b11), __builtin_bit_cast(bf16x8, pw1), o[1], 0, 0, 0);
        if (more) pc = pn;
    }
#undef ATT_SB
#undef ATT_E
#undef ATT_KF
#undef ATT_V8
}
struct TabCI { const LAS float* tb; __device__ __forceinline__ float operator()(int kc) const { return tb[kc]; } };
struct NoPM { __device__ __forceinline__ float operator()(float t, int) const { return t; } };
struct WinPM {
    int wm;
    __device__ __forceinline__ float operator()(float t, int kc) const {
        const int m = __builtin_amdgcn_sbfe(wm, kc, 1);
        return __builtin_bit_cast(float, (__builtin_bit_cast(unsigned, t) & (unsigned)m) | (~(unsigned)m & 0xff800000u)); }
};
__device__ __forceinline__ float wave_max(float v) {
#pragma unroll
    for (int o = 1; o < 64; o <<= 1) v = fmaxf(v, __shfl_xor(v, o));
    return v;
}
__device__ __forceinline__ float qk_bound(const float* gq, const float* gk, int lane) { return 64.f * C2 * wave_max(fabsf(gq[lane])) * wave_max(fabsf(gk[lane])); }
}
struct Args { const float* in[24]; float* out; unsigned char* ws; int ph_lo, ph_hi, li, pad; };
typedef Args Ptrs;
constexpr int NWAVES = 8;

struct ConvItem { const float* W; const float* gain; bf16_t* WT; int N, Kd, k0, n0, drow0, f8; };
__device__ __forceinline__ void conv_load(f32x4 (&v)[16], const ConvItem& it, int lane) {
    const float* src = it.W + (size_t)(it.k0 + (lane >> 4)) * it.N + it.n0 + 4 * (lane & 15);
#pragma unroll
    for (int i = 0; i < 16; ++i) v[i] = __builtin_nontemporal_load((const f32x4*)(src + (size_t)(4 * i) * it.N));
}
__device__ __forceinline__ void conv_to_lds(const f32x4 (&v)[16], const ConvItem& it, LAS float* scr, int lane) {
#pragma unroll
    for (int i = 0; i < 16; ++i) { const int kk = 4 * i + (lane >> 4); const float gk = it.gain ? it.gain[it.k0 + kk] : 1.f; LAS float* d = scr + kk * 65 + 4 * (lane & 15);
        d[0] = v[i].x * gk; d[1] = v[i].y * gk; d[2] = v[i].z * gk; d[3] = v[i].w * gk; }
    LDS_WAIT(); asm volatile("" ::: "memory");
}
__device__ __forceinline__ void conv_from_lds(const ConvItem& it, LAS float* scr, int lane) {
    const int c = lane & 7;
#pragma unroll
    for (int j = 0; j < 8; ++j) { const int n = (lane >> 3) + 8 * j; const LAS float* s = scr + (8 * c) * 65 + n;
        u32x4 o; o.x = pk2(s[0 * 65], s[1 * 65]); o.y = pk2(s[2 * 65], s[3 * 65]); o.z = pk2(s[4 * 65], s[5 * 65]); o.w = pk2(s[6 * 65], s[7 * 65]);
        __builtin_nontemporal_store(o, (u32x4*)(it.WT + (size_t)(it.drow0 + n) * it.Kd + it.k0 + 8 * c)); }
    LDS_WAIT(); asm volatile("" ::: "memory");
}
__device__ __forceinline__ void conv_from_lds8(const ConvItem& it, LAS float* scr, int lane) {
    const int c = lane & 3; unsigned char* WT8 = (unsigned char*)it.WT;
#pragma unroll
    for (int j = 0; j < 4; ++j) { const int n = (lane >> 2) + 16 * j; const LAS float* s = scr + (16 * c) * 65 + n;
        u32x4 o;
#pragma unroll
        for (int q = 0; q < 4; ++q) { int w = 0;
            w = __builtin_amdgcn_cvt_pk_fp8_f32(s[(4 * q + 0) * 65] * W8_SCALE, s[(4 * q + 1) * 65] * W8_SCALE, w, false);
            w = __builtin_amdgcn_cvt_pk_fp8_f32(s[(4 * q + 2) * 65] * W8_SCALE, s[(4 * q + 3) * 65] * W8_SCALE, w, true); o[q] = (unsigned)w; }
        __builtin_nontemporal_store(o, (u32x4*)(WT8 + (size_t)(it.drow0 + n) * it.Kd + it.k0 + 16 * c)); }
    LDS_WAIT(); asm volatile("" ::: "memory");
}
__device__ __forceinline__ void conv_out(const ConvItem& it, LAS float* scr, int lane) { if (it.f8) conv_from_lds8(it, scr, lane); else conv_from_lds(it, scr, lane); }
__device__ __forceinline__ ConvItem conv_matrix_item(const float* W, int K, int N, const float* gain, bf16_t* WT, int ileave, int item) {
    const int nnb = N / 64, kb = item / nnb, nb = item % nnb, n0 = 64 * nb;
    ConvItem it; it.W = W; it.gain = gain; it.WT = WT; it.N = N; it.Kd = K; it.k0 = 64 * kb; it.n0 = n0; it.f8 = 0;
    it.drow0 = ileave == 0 ? n0 : ((n0 >> 7) * 256 + (n0 & 127) + (ileave == 2 ? 128 : 0));
    return it;
}
__device__ __forceinline__ ConvItem p0_expert_item(const Ptrs& P, int r) {
    unsigned char* ws = P.ws;
    constexpr int I_GE = (D / 64) * (FFE / 64), I_DE = (FFE / 64) * (D / 64);
    const int per_e = 2 * I_GE + I_DE; const int e = r / per_e; r -= e * per_e;
    if (r < I_GE) { ConvItem c = conv_matrix_item(P.in[21] + (size_t)e * D * FFE, D, FFE, P.in[19], (bf16_t*)(ws + WS_WGUE + (size_t)e * 2 * FFE * D), 1, r); c.f8 = 1; return c; } r -= I_GE;
    if (r < I_GE) { ConvItem c = conv_matrix_item(P.in[22] + (size_t)e * D * FFE, D, FFE, P.in[19], (bf16_t*)(ws + WS_WGUE + (size_t)e * 2 * FFE * D), 2, r); c.f8 = 1; return c; } r -= I_GE;
    { ConvItem c = conv_matrix_item(P.in[23] + (size_t)e * FFE * D, FFE, D, nullptr, (bf16_t*)(ws + WS_WDE + (size_t)e * D * FFE), 0, r); c.f8 = 1; return c; }
}
constexpr int P0_DEFER_A = 192 * 8 * 3, P0_DEFER_B = 128 * 8 * 3, P0_C_PER_WAVE = 16, P0_DEFER_C = 256 * 4 * P0_C_PER_WAVE, P0_DEFER = P0_DEFER_A + P0_DEFER_B;
__device__ __forceinline__ ConvItem p0_item(const Ptrs& P, int r) {
    unsigned char* ws = P.ws;
    constexpr int I_IN = (D / 64) * (N_IN0 / 64), I_O = (D / 64) * (D / 64), I_G0 = (D / 64) * (FF0 / 64), I_D0 = (FF0 / 64) * (D / 64), I_Q1 = (D / 64) * (N_QKV1 / 64);
    constexpr int I_E = NE * 3 * (D / 64) * (FFE / 64), I_E1 = I_E - P0_DEFER_B, I_DENSE = 2 * I_O + 2 * I_G0 + I_D0 + I_Q1;
    if (r < I_IN) return conv_matrix_item(P.in[2], D, N_IN0, P.in[1], (bf16_t*)(ws + WS_WIN), 0, r); r -= I_IN;
    if (r < I_E1) return p0_expert_item(P, r); r -= I_E1;
    if (r >= I_DENSE) return p0_expert_item(P, I_E1 + r - I_DENSE);
    if (r < I_O) return conv_matrix_item(P.in[8], D, D, nullptr, (bf16_t*)(ws + WS_WOUT0), 0, r); r -= I_O;
    if (r < I_G0) return conv_matrix_item(P.in[10], D, FF0, P.in[9], (bf16_t*)(ws + WS_WGU0), 1, r); r -= I_G0;
    if (r < I_G0) return conv_matrix_item(P.in[11], D, FF0, P.in[9], (bf16_t*)(ws + WS_WGU0), 2, r); r -= I_G0;
    if (r < I_D0) return conv_matrix_item(P.in[12], FF0, D, nullptr, (bf16_t*)(ws + WS_WD0), 0, r); r -= I_D0;
    if (r < I_Q1) return conv_matrix_item(P.in[14], D, N_QKV1, P.in[13], (bf16_t*)(ws + WS_WQKV1), 0, r); r -= I_Q1;
    return conv_matrix_item(P.in[18], D, D, nullptr, (bf16_t*)(ws + WS_WOUT1), 0, r);
}
constexpr int P0_ITEMS = (D / 64) * (N_IN0 / 64) + 2 * (D / 64) * (D / 64) + 3 * (D / 64) * (FF0 / 64) + (D / 64) * (N_QKV1 / 64) + NE * 3 * (D / 64) * (FFE / 64);
static_assert(P0_DEFER_A >= 2 * (D / 64) * (D / 64) + 3 * (D / 64) * (FF0 / 64) + (D / 64) * (N_QKV1 / 64), "block A holds every dense matrix but w_in");
static_assert(P0_ITEMS - P0_DEFER - P0_DEFER_C >= (D / 64) * (N_IN0 / 64), "block C holds expert (e4m3) items only; w_in stays in the prologue");
__device__ __forceinline__ void p0_tail_items(const Ptrs& P, LAS unsigned char* lds, int first, int n, int wave, int lane) {
    LAS float* scr = (LAS float*)(lds + wave * 16640); f32x4 v[16];
    for (int j = 0; j < n; ++j) { const ConvItem c = p0_item(P, first + j); conv_load(v, c, lane); conv_to_lds(v, c, scr, lane); conv_out(c, scr, lane); }
}
__device__ __forceinline__ void convr_load(f32x4 (&v)[16], float (&g)[16], const ConvItem& it, int lane) {
    const float* src = it.W + (size_t)(it.k0 + 16 * (lane >> 4)) * it.N + it.n0 + 4 * (lane & 15);
#pragma unroll
    for (int i = 0; i < 16; ++i) v[i] = __builtin_nontemporal_load((const f32x4*)(src + (size_t)i * it.N));
#pragma unroll
    for (int i = 0; i < 16; ++i) g[i] = it.gain ? it.gain[it.k0 + 16 * (lane >> 4) + i] : 1.f;
}
__device__ __forceinline__ void convr_out8(const f32x4 (&v)[16], const float (&g)[16], const ConvItem& it, int lane) {
    unsigned char* dst = (unsigned char*)it.WT + (size_t)(it.drow0 + 4 * (lane & 15)) * it.Kd + it.k0 + 16 * (lane >> 4);
#pragma unroll
    for (int j = 0; j < 4; ++j) { u32x4 o;
#pragma unroll
        for (int q = 0; q < 4; ++q) { int w = 0;
            w = __builtin_amdgcn_cvt_pk_fp8_f32(v[4 * q][j] * (g[4 * q] * W8_SCALE), v[4 * q + 1][j] * (g[4 * q + 1] * W8_SCALE), w, false);
            w = __builtin_amdgcn_cvt_pk_fp8_f32(v[4 * q + 2][j] * (g[4 * q + 2] * W8_SCALE), v[4 * q + 3][j] * (g[4 * q + 3] * W8_SCALE), w, true); o[q] = (unsigned)w; }
        __builtin_nontemporal_store(o, (u32x4*)(dst + (size_t)j * it.Kd)); }
}
__device__ __forceinline__ void p0_prologue(const Ptrs& P, LAS unsigned char* lds, int gw, int NGW, int wave, int lane, int G) {
    LAS float* scr = (LAS float*)(lds + wave * 16640);
    unsigned char* ws = P.ws;
    const int NITEMS = (G == 256) ? P0_ITEMS - P0_DEFER - P0_DEFER_C : P0_ITEMS;
    f32x4 va[16], vb[16];
    int it = gw;
    if (it < NITEMS) { const ConvItem c0 = p0_item(P, it); conv_load(va, c0, lane); }
#pragma unroll 1
    for (; it < NITEMS; it += 2 * NGW) {
        { const ConvItem c0 = p0_item(P, it); conv_to_lds(va, c0, scr, lane);
          if (it + NGW < NITEMS) { const ConvItem c1 = p0_item(P, it + NGW); conv_load(vb, c1, lane); }
          conv_out(c0, scr, lane); }
        if (it + NGW < NITEMS) { const ConvItem c1 = p0_item(P, it + NGW); conv_to_lds(vb, c1, scr, lane);
          if (it + 2 * NGW < NITEMS) { const ConvItem c2 = p0_item(P, it + 2 * NGW); conv_load(va, c2, lane); }
          conv_out(c1, scr, lane); }
    }
    const float* x = P.in[0]; bf16_t* xb = (bf16_t*)(ws + WS_XB); float* ss0 = (float*)(ws + WS_SS);
    for (int m = gw; m < M; m += NGW) {
        const f32x4* xr = (const f32x4*)(x + (size_t)m * D) + lane; f32x4 v[4]; float s = 0.f;
#pragma unroll
        for (int j = 0; j < 4; ++j) { v[j] = __builtin_nontemporal_load(xr + 64 * j); s += (v[j].x * v[j].x + v[j].y * v[j].y) + (v[j].z * v[j].z + v[j].w * v[j].w); }
        s = wave_sum(s);
        u32x2* o8 = (u32x2*)(xb + (size_t)m * D) + lane;
#pragma unroll
        for (int j = 0; j < 4; ++j) { u32x2 w; w.x = pk2(v[j].x, v[j].y); w.y = pk2(v[j].z, v[j].w); o8[64 * j] = w; }
        if (lane == 0) *(f32x4*)(ss0 + (size_t)m * 4) = (f32x4){s, 0.f, 0.f, 0.f};
    }
}

struct ADesc { int b, h, r, cfg, p, l0, seg, tokb; };
template <bool FINAL>
__device__ __forceinline__ ADesc decodeA(int a) {
    ADesc d; const int cfg = FINAL ? 2 : (a >> 9), rem = a & 511; d.cfg = cfg; d.b = rem >> 7; d.h = (rem >> 4) & 7; d.r = cfg == 0 ? 1 : (cfg == 1 ? 4 : 16);
    const int idx16 = rem & 15, nblk = 16 / d.r; d.p = idx16 / nblk; d.l0 = 256 * (idx16 % nblk); d.seg = SEQ / d.r; d.tokb = d.b * SEQ + d.p; return d; }
__device__ __forceinline__ void fetchA(const Ptrs& P, const ADesc& d, u32x4 (&kq)[6], u32x4 (&vq)[6], bf16x8 (&qn)[4], int wid, int lane) {
    const bf16_t* QKV = (const bf16_t*)(P.ws + WS_QKV); const bf16_t* Kg = QKV + (size_t)(8 + d.h) * M * 64; const bf16_t* Vg = QKV + (size_t)(16 + d.h) * M * 64;
#pragma unroll
    for (int t = 0; t < 6; ++t) {
        int kd = d.l0 - 64 + 64 * t + 8 * wid + (lane >> 3); kd = kd < 0 ? 0 : (kd > d.seg - 1 ? d.seg - 1 : kd);
        int vd = d.l0 - 64 + 64 * t + 16 * (wid & 3) + (lane >> 2); vd = vd < 0 ? 0 : (vd > d.seg - 1 ? d.seg - 1 : vd);
        att::fetch_tile(kq[t], vq[t], Kg, Vg, 64, d.tokb + kd * d.r, d.tokb + vd * d.r, wid, lane); }
    const int tok = d.tokb + (d.l0 + 32 * wid + (lane & 31)) * d.r;
#pragma unroll
    for (int d0 = 0; d0 < 4; ++d0) qn[d0] = *(const bf16x8*)(QKV + ((size_t)d.h * M + tok) * 64 + 16 * d0 + 8 * (lane >> 5));
}
__device__ __forceinline__ void fetchPart(const Ptrs& P, const ADesc& d, u32x2 (&pp)[16], float (&pl)[2], int wid, int lane) {
    const int hi = lane >> 5; const int tok = d.tokb + (d.l0 + 32 * wid + (lane & 31)) * d.r;
    const bf16_t* p1 = (const bf16_t*)(P.ws + WS_PA1) + (size_t)tok * 512 + d.h * 64; const bf16_t* p4 = (const bf16_t*)(P.ws + WS_PA4) + (size_t)tok * 512 + d.h * 64;
#pragma unroll
    for (int i = 0; i < 8; ++i) { const int c = 32 * (i >> 2) + 8 * (i & 3) + 4 * hi; pp[i] = *(const u32x2*)(p1 + c); pp[8 + i] = *(const u32x2*)(p4 + c); }
    const float* LS = (const float*)(P.ws + WS_LSE); pl[0] = LS[(size_t)tok * 8 + d.h]; pl[1] = LS[(size_t)M * 8 + (size_t)tok * 8 + d.h];
}
template <bool FINAL>
__device__ __forceinline__ void attnA_run(const Ptrs& P, LAS unsigned char* lds, int afirst, int astep, int aend, int wid, int lane, int tid) {
    const int r32 = lane & 31, hi = lane >> 5;
    LAS unsigned char* Kb = lds; LAS unsigned char* Vb = lds + 6 * att::TILE_B; LAS float* tab = (LAS float*)(lds + 12 * att::TILE_B);
    LAS unsigned char* stg = lds + 12 * att::TILE_B + 1024 + wid * 4096;
    if (afirst >= aend) return;
    const float shift = att::qk_bound(P.in[3], P.in[4], lane);
    unsigned so[4], vo[4];
    { const unsigned x = (unsigned)(r32 >> 1) & 7u;
#pragma unroll
      for (int d0 = 0; d0 < 4; ++d0) so[d0] = (((unsigned)(2 * d0 + hi)) ^ x) << 4;
      const unsigned vl = (unsigned)(((lane >> 4) & 1) * 32 + (lane & 3) * 8 + (4 * hi + ((lane & 15) >> 2)) * 64);
      vo[0] = vl; vo[1] = vl + 512u; vo[2] = vl + 1024u; vo[3] = vl + 1536u; }
    u32x4 kq[6], vq[6]; bf16x8 qn[4]; u32x2 pp[16]; float pl[2] = {0.f, 0.f};
    { const ADesc d0_ = decodeA<FINAL>(afirst); fetchA(P, d0_, kq, vq, qn, wid, lane); if (FINAL) fetchPart(P, d0_, pp, pl, wid, lane); }
    bf16_t* prow = nullptr; int prstep = 0; float* pls = nullptr; float plv = 0.f;
#pragma unroll 1
    for (int a = afirst; a < aend; a += astep) {
        const ADesc d = decodeA<FINAL>(a);
#pragma unroll
        for (int t = 0; t < 6; ++t) att::commit_tile(Kb + t * att::TILE_B, Vb + t * att::TILE_B, kq[t], vq[t], wid, lane);
        bf16x8 qr[4];
#pragma unroll
        for (int d0 = 0; d0 < 4; ++d0) qr[d0] = qn[d0];
        u32x2 pc[16]; float plc[2];
        if (FINAL) {
#pragma unroll
            for (int i = 0; i < 16; ++i) pc[i] = pp[i];
            plc[0] = pl[0]; plc[1] = pl[1]; }
        const float cs = __builtin_amdgcn_exp2f(-(float)(2 * d.h + 1) * 0.5f) * (float)d.r * LOG2E;
        if (tid < 256) { const float ad = fabsf((float)(128 - tid)); tab[tid] = ad <= 64.f ? -cs * ad - shift : -INFINITY; }
        LDS_WAIT(); __syncthreads();
        if (prow) { att::flush_o<true>(stg, lane, [&](int row) { return prow + (size_t)row * prstep; }); if (!FINAL && hi == 0) *pls = plv; }
        { const ADesc dn = decodeA<FINAL>(a + astep < aend ? a + astep : a); fetchA(P, dn, kq, vq, qn, wid, lane); if (FINAL) fetchPart(P, dn, pp, pl, wid, lane); }
        const int qd = d.l0 + 32 * wid + r32; const int tok = d.tokb + qd * d.r;
        f32x16 o[2];
#pragma unroll
        for (int i = 0; i < 16; ++i) { o[0][i] = 0.f; o[1][i] = 0.f; }
        float lrun = 0.f;
#pragma unroll 1
        for (int hs = 0; hs < 5; ++hs) {
            const int hh = wid + hs, ks0 = d.l0 - 64 + 32 * hh;
            if (ks0 < 0 || ks0 >= d.seg) continue;
            att::TabCI ci; ci.tb = tab + (128 - (qd - ks0 - 4 * hi));
            att::half_step(Kb + (32 * hh + r32) * 128, so, Vb + (hh >> 1) * att::TILE_B + (hh & 1) * 2048, vo, qr, o, lrun, ci, att::NoPM{});
        }
        const float ltot = lrun + __shfl_xor(lrun, 32);
        if (!FINAL) {
            att::stage_o<true>(stg, o, 1.0f, r32, hi);
            prow = (bf16_t*)(P.ws + (d.cfg == 0 ? WS_PA1 : WS_PA4)) + (size_t)(d.tokb + (d.l0 + 32 * wid) * d.r) * 512 + d.h * 64; prstep = d.r * 512;
            pls = (float*)(P.ws + WS_LSE) + (size_t)d.cfg * M * 8 + (size_t)tok * 8 + d.h; plv = ltot;
        } else {
            const float inv = 1.0f / (ltot + plc[0] + plc[1]);
#pragma unroll
            for (int i = 0; i < 8; ++i) { const int d0 = i >> 2, gq = i & 3; const u32x2 a_ = pc[i], bq = pc[8 + i];
                o[d0][4 * gq] += bf_lo(a_.x) + bf_lo(bq.x); o[d0][4 * gq + 1] += bf_hi(a_.x) + bf_hi(bq.x); o[d0][4 * gq + 2] += bf_lo(a_.y) + bf_lo(bq.y); o[d0][4 * gq + 3] += bf_hi(a_.y) + bf_hi(bq.y); }
            att::stage_o<true>(stg, o, inv, r32, hi);
            prow = (bf16_t*)(P.ws + WS_AO) + (size_t)(d.tokb + (d.l0 + 32 * wid) * d.r) * D + d.h * 64; prstep = d.r * D;
        }
        LDS_WAIT(); __syncthreads();
    }
    if (prow) { att::flush_o<true>(stg, lane, [&](int row) { return prow + (size_t)row * prstep; }); if (!FINAL && hi == 0) *pls = plv; }
    __syncthreads();
}
__device__ __forceinline__ void fetchB(const Ptrs& P, int u, u32x4 (&kq)[5], u32x4 (&vq)[5], bf16x8 (&qn)[4], int wid, int lane) {
    const int b = u >> 7, kvh = (u >> 6) & 1, q0 = 64 * (u & 63), tokb = b * SEQ;
    const bf16_t* QKV = (const bf16_t*)(P.ws + WS_QKV); const bf16_t* Kg = QKV + (size_t)(32 + kvh) * M * 64; const bf16_t* Vg = QKV + (size_t)(34 + kvh) * M * 64;
#pragma unroll
    for (int t = 0; t < 5; ++t) {
        int kd = q0 - 128 + 64 * t + 8 * wid + (lane >> 3); kd = kd < 0 ? 0 : (kd > SEQ - 1 ? SEQ - 1 : kd);
        int vd = q0 - 128 + 64 * t + 16 * (wid & 3) + (lane >> 2); vd = vd < 0 ? 0 : (vd > SEQ - 1 ? SEQ - 1 : vd);
        att::fetch_tile(kq[t], vq[t], Kg, Vg, 64, tokb + kd, tokb + vd, wid, lane); }
    const int hq = 4 * kvh + (wid & 3), tok = tokb + q0 + 32 * (wid >> 2) + (lane & 31);
#pragma unroll
    for (int d0 = 0; d0 < 4; ++d0) qn[d0] = *(const bf16x8*)(QKV + ((size_t)(24 + hq) * M + tok) * 64 + 16 * d0 + 8 * (lane >> 5));
}
__device__ __forceinline__ void attnB_run(const Ptrs& P, LAS unsigned char* lds, int ufirst, int ustep, int uend, int wid, int lane, int tid) {
    const int r32 = lane & 31, hi = lane >> 5;
    LAS unsigned char* Kb = lds; LAS unsigned char* Vb = lds + 5 * att::TILE_B; LAS float* tab = (LAS float*)(lds + 10 * att::TILE_B);
    LAS unsigned char* stg = lds + 10 * att::TILE_B + 6144 + wid * 4096;
    if (ufirst >= uend) return;
    const float shift = att::qk_bound(P.in[5], P.in[6], lane);
    unsigned so[4], vo[4];
    { const unsigned x = (unsigned)(r32 >> 1) & 7u;
#pragma unroll
      for (int d0 = 0; d0 < 4; ++d0) so[d0] = (((unsigned)(2 * d0 + hi)) ^ x) << 4;
      const unsigned vl = (unsigned)(((lane >> 4) & 1) * 32 + (lane & 3) * 8 + (4 * hi + ((lane & 15) >> 2)) * 64);
      vo[0] = vl; vo[1] = vl + 512u; vo[2] = vl + 1024u; vo[3] = vl + 1536u; }
    u32x4 kq[5], vq[5]; bf16x8 qn[4];
    const float sink0 = __builtin_amdgcn_exp2f(P.in[7][wid & 3] * LOG2E - shift), sink1 = __builtin_amdgcn_exp2f(P.in[7][4 + (wid & 3)] * LOG2E - shift);
    fetchB(P, ufirst, kq, vq, qn, wid, lane);
    bf16_t* prow = nullptr;
#pragma unroll 1
    for (int u = ufirst; u < uend; u += ustep) {
        const int b = u >> 7, kvh = (u >> 6) & 1, q0 = 64 * (u & 63), tokb = b * SEQ;
#pragma unroll
        for (int t = 0; t < 5; ++t) att::commit_tile(Kb + t * att::TILE_B, Vb + t * att::TILE_B, kq[t], vq[t], wid, lane);
        bf16x8 qr[4];
#pragma unroll
        for (int d0 = 0; d0 < 4; ++d0) qr[d0] = qn[d0];
#pragma unroll
        for (int i = 0; i < 3; ++i) { const int e = tid + 512 * i, hd_ = e / 384, y = e - hd_ * 384; const float ad = fabsf((float)(192 - y));
            const float csl = __builtin_amdgcn_exp2f(-(float)(4 * kvh + hd_ + 1)) * LOG2E;
            tab[e] = ad <= 128.f ? -csl * ad - shift : -INFINITY; }
        const int hd = wid & 3, hq = 4 * kvh + hd; const int qd = q0 + 32 * (wid >> 2) + r32;
        const float sinkp = kvh ? sink1 : sink0;
        LDS_WAIT(); __syncthreads();
        if (prow) att::flush_o<true>(stg, lane, [&](int row) { return prow + (size_t)row * D; });
        fetchB(P, u + ustep < uend ? u + ustep : u, kq, vq, qn, wid, lane);
        f32x16 o[2];
#pragma unroll
        for (int i = 0; i < 16; ++i) { o[0][i] = 0.f; o[1][i] = 0.f; }
        float lrun = hi == 0 ? sinkp : 0.f;
#pragma unroll 1
        for (int hs = 0; hs < 9; ++hs) {
            const int hh = (wid >> 2) + hs, ks0 = q0 - 128 + 32 * hh;
            if (ks0 < 0 || ks0 >= SEQ) continue;
            att::TabCI ci; ci.tb = tab + hd * 384 + (192 - (qd - ks0 - 4 * hi));
            att::half_step(Kb + (32 * hh + r32) * 128, so, Vb + (hh >> 1) * att::TILE_B + (hh & 1) * 2048, vo, qr, o, lrun, ci, att::NoPM{});
        }
        const float ltot = lrun + __shfl_xor(lrun, 32);
        att::stage_o<true>(stg, o, 1.0f / ltot, r32, hi);
        prow = (bf16_t*)(P.ws + WS_AO) + (size_t)(tokb + q0 + 32 * (wid >> 2)) * D + 512 + hq * 64;
        LDS_WAIT(); __syncthreads();
    }
    if (prow) att::flush_o<true>(stg, lane, [&](int row) { return prow + (size_t)row * D; });
    __syncthreads();
}
__device__ __forceinline__ void attnC_column(const Ptrs& P, LAS unsigned char* lds, int b, int h, int ip0, int nip, int wid, int lane, int tid, int cfirst) {
    const int r32 = lane & 31, hi = lane >> 5;
    const bf16_t* QKV = (const bf16_t*)(P.ws + WS_QKV);
    const bf16_t* Kg = QKV + (size_t)(16 + h) * M * 64; const bf16_t* Vg = QKV + (size_t)(32 + h) * M * 64;
    const int tokb = b * SEQ;
    LAS unsigned char* Kb = lds; LAS unsigned char* Vb = lds + 9 * att::TILE_B; LAS float* tab = (LAS float*)(lds + RPB_OFF);
    const float shift = att::qk_bound(P.in[15], P.in[16], lane);
#pragma unroll
    for (int i = 0; i < 2; ++i) { const int e = tid + 512 * i, row = e >> 6, co = (e & 63) - 16;
        tab[e] = (row < 15 && co >= 0 && co < 31) ? P.in[17][(size_t)h * 465 + row * 31 + co] * LOG2E - shift : -INFINITY; }
    int have;
    { const int i0 = 2 * ip0; const int rs0 = i0 - 4 < 0 ? 0 : (i0 - 4 > 56 ? 56 : i0 - 4); const int last = rs0 + 8 > 63 ? 63 : rs0 + 8;
#pragma unroll 1
      for (int kr = rs0; kr <= last; ++kr) { const int sl = kr % 9;
          att::stage_tile(Kb + sl * att::TILE_B, Vb + sl * att::TILE_B, Kg, Vg, 64, tokb + kr * 64 + 8 * wid + (lane >> 3), tokb + kr * 64 + 16 * (wid & 3) + (lane >> 2), wid, lane); }
      have = last; }
    u32x4 kn[2], vn[2]; int nnew = 0, newrow = 0;
#define ATTC_COMMIT() do { if (nnew > 0) att::commit_tile(Kb + (newrow % 9) * att::TILE_B, Vb + (newrow % 9) * att::TILE_B, kn[0], vn[0], wid, lane); \
        if (nnew > 1) att::commit_tile(Kb + ((newrow + 1) % 9) * att::TILE_B, Vb + ((newrow + 1) % 9) * att::TILE_B, kn[1], vn[1], wid, lane); } while (0)
#define ATTC_FETCH(i0_) do { nnew = 0; if (s + 1 < nip) { const int i1_ = (i0_) + 2; const int rs1_ = i1_ - 4 < 0 ? 0 : (i1_ - 4 > 56 ? 56 : i1_ - 4); const int last1_ = rs1_ + 8 > 63 ? 63 : rs1_ + 8; \
        nnew = last1_ - have; newrow = have + 1; \
        if (nnew > 0) att::fetch_tile(kn[0], vn[0], Kg, Vg, 64, tokb + newrow * 64 + 8 * wid + (lane >> 3), tokb + newrow * 64 + 16 * (wid & 3) + (lane >> 2), wid, lane); \
        if (nnew > 1) att::fetch_tile(kn[1], vn[1], Kg, Vg, 64, tokb + (newrow + 1) * 64 + 8 * wid + (lane >> 3), tokb + (newrow + 1) * 64 + 16 * (wid & 3) + (lane >> 2), wid, lane); \
        have = last1_; } } while (0)
    if (wid >= 4) {
        f32x4 cv[16], cw[16]; float cg[16], ch[16]; int pa = -1, pb = -1;
        VM_WAIT();
#pragma unroll 1
        for (int s = 0; s < nip; ++s) {
            const int i0 = 2 * (ip0 + s);
            ATTC_COMMIT();
            LDS_WAIT(); __syncthreads();
            ATTC_FETCH(i0);
            if (pa >= 0) { const ConvItem c = p0_item(P, pa); convr_out8(cv, cg, c, lane); }
            if (pb >= 0) { const ConvItem c = p0_item(P, pb); convr_out8(cw, ch, c, lane); }
            pa = (cfirst >= 0 && 2 * s < P0_C_PER_WAVE) ? cfirst + (wid - 4) * P0_C_PER_WAVE + 2 * s : -1;
            pb = (cfirst >= 0 && 2 * s + 1 < P0_C_PER_WAVE) ? cfirst + (wid - 4) * P0_C_PER_WAVE + 2 * s + 1 : -1;
            if (pa >= 0) { const ConvItem c = p0_item(P, pa); convr_load(cv, cg, c, lane); }
            if (pb >= 0) { const ConvItem c = p0_item(P, pb); convr_load(cw, ch, c, lane); }
            __syncthreads();
        }
        if (pa >= 0) { const ConvItem c = p0_item(P, pa); convr_out8(cv, cg, c, lane); }
        if (pb >= 0) { const ConvItem c = p0_item(P, pb); convr_out8(cw, ch, c, lane); }
    } else {
    LAS unsigned char* stg = lds + OSTAGE_OFF + (wid & 3) * 2048;
    const int cb = wid & 3;
    const int j = 16 * cb + (r32 & 15);
    const int cs0 = j - 8 < 0 ? 0 : (j - 8 > 48 ? 48 : j - 8);
    const int kcol0 = 16 * cb - 8 < 0 ? 0 : (16 * cb - 8 > 32 ? 32 : 16 * cb - 8);
    const int wm = (int)((0xFFFFu << (cs0 - kcol0)) >> (4 * hi));
    unsigned so[4], vo[4];
    { const unsigned x = (unsigned)((kcol0 + r32) >> 1) & 7u;
#pragma unroll
      for (int d0 = 0; d0 < 4; ++d0) so[d0] = (((unsigned)(2 * d0 + hi)) ^ x) << 4;
      const unsigned colb = (unsigned)(((lane >> 4) & 1) * 32 + (lane & 3) * 8);
#pragma unroll
      for (int m = 0; m < 4; ++m) { const int k = kcol0 + 8 * m + 4 * hi + ((lane & 15) >> 2); vo[m] = (unsigned)(((k >> 4) & 3) * 1024 + (k & 15) * 64) + colb; } }
    const int tb0 = kcol0 + 4 * hi - j + 31;
    bf16x8 qn[4];
    { const int tok = tokb + (2 * ip0 + (r32 >> 4)) * 64 + j;
#pragma unroll
      for (int d0 = 0; d0 < 4; ++d0) qn[d0] = *(const bf16x8*)(QKV + ((size_t)h * M + tok) * 64 + 16 * d0 + 8 * hi); }
    u32x2 opk[8]; bf16_t* prow = nullptr;
    VM_WAIT();
#pragma unroll 1
    for (int s = 0; s < nip; ++s) {
        const int i0 = 2 * (ip0 + s);
        const int rs0 = i0 - 4 < 0 ? 0 : (i0 - 4 > 56 ? 56 : i0 - 4);
        ATTC_COMMIT();
        bf16x8 qr[4];
#pragma unroll
        for (int d0 = 0; d0 < 4; ++d0) qr[d0] = qn[d0];
        LDS_WAIT(); __syncthreads();
        if (prow) {
#pragma unroll
            for (int d0 = 0; d0 < 2; ++d0) {
#pragma unroll
                for (int gq = 0; gq < 4; ++gq) *(LAS u32x2*)(stg + r32 * 64 + (8 * gq + 4 * hi) * 2) = opk[4 * d0 + gq];
                LDS_WAIT();
#pragma unroll
                for (int i = 0; i < 2; ++i) { const int row = i * 16 + (lane >> 2), ch = lane & 3; const u32x4 v = *(const LAS u32x4*)(stg + row * 64 + ch * 16);
                    *(u32x4*)(prow + (size_t)((row >> 4) * 64 + (row & 15)) * D + 32 * d0 + ch * 8) = v; }
                LDS_WAIT();
            }
        }
        ATTC_FETCH(i0);
        if (s + 1 < nip) {
            const int tok1 = tokb + (i0 + 2 + (r32 >> 4)) * 64 + j;
#pragma unroll
            for (int d0 = 0; d0 < 4; ++d0) qn[d0] = *(const bf16x8*)(QKV + ((size_t)h * M + tok1) * 64 + 16 * d0 + 8 * hi);
        }
        {
            const int qi = i0 + (r32 >> 4);
            f32x16 o[2];
#pragma unroll
            for (int q = 0; q < 16; ++q) { o[0][q] = 0.f; o[1][q] = 0.f; }
            float lrun = 0.f;
            const int rsi = qi - 4 < 0 ? 0 : (qi - 4 > 56 ? 56 : qi - 4);
            att::pipe_rows<9>([&](int t) { const int kr = rs0 + t; const int sl = kr % 9; const bool rowok = kr >= rsi && kr <= rsi + 7; const int ro = rowok ? kr - qi + 7 : 15;
                    att::HS hs; hs.ka = Kb + (sl * 64 + kcol0 + r32) * 128; hs.vb = Vb + sl * att::TILE_B; hs.tb = tab + ro * 64 + tb0; return hs; }, so, vo, qr, o, lrun, wm);
            const float inv = 1.0f / (lrun + __shfl_xor(lrun, 32));
#pragma unroll
            for (int i = 0; i < 8; ++i) { const int d0 = i >> 2, gq = i & 3; opk[i].x = cvt_pk_bf16(o[d0][4 * gq] * inv, o[d0][4 * gq + 1] * inv); opk[i].y = cvt_pk_bf16(o[d0][4 * gq + 2] * inv, o[d0][4 * gq + 3] * inv); }
            prow = (bf16_t*)(P.ws + WS_AO) + (size_t)(tokb + i0 * 64 + 16 * cb) * D + h * 64;
        }
        __syncthreads();
    }
    if (prow) {
#pragma unroll
        for (int d0 = 0; d0 < 2; ++d0) {
#pragma unroll
            for (int gq = 0; gq < 4; ++gq) *(LAS u32x2*)(stg + r32 * 64 + (8 * gq + 4 * hi) * 2) = opk[4 * d0 + gq];
            LDS_WAIT();
#pragma unroll
            for (int i = 0; i < 2; ++i) { const int row = i * 16 + (lane >> 2), ch = lane & 3; const u32x4 v = *(const LAS u32x4*)(stg + row * 64 + ch * 16);
                *(u32x4*)(prow + (size_t)((row >> 4) * 64 + (row & 15)) * D + 32 * d0 + ch * 8) = v; }
            LDS_WAIT();
        }
    }
    }
#undef ATTC_COMMIT
#undef ATTC_FETCH
    __syncthreads();
}

__device__ __forceinline__ void route_phase(const Ptrs& P, LAS unsigned char* lds, gu32* ctl, int bx, int G, int wave, int lane, int tid) {
    LAS float* wl = (LAS float*)lds;
    LAS unsigned* lc = (LAS unsigned*)(lds + 32768);
    LAS unsigned* rec = (LAS unsigned*)(lds + 32768 + 64);
    for (int i = tid; i < D * NE; i += NWAVES * 64) wl[i] = P.in[20][i] * P.in[19][i >> 3];
    if (tid < 16) lc[tid] = 0u;
    __syncthreads();
    unsigned* rowtok = (unsigned*)(P.ws + WS_ROWTOK); float* rowgate = (float*)(P.ws + WS_ROWGATE); float* rowrs = (float*)(P.ws + WS_ROWRS);
    f32x4 wreg[2][8][2];
#pragma unroll
    for (int jj = 0; jj < 2; ++jj)
#pragma unroll
        for (int c = 0; c < 8; ++c) { const LAS f32x4* w = (const LAS f32x4*)(wl + (size_t)(8 * (64 * jj + lane) + c) * 8); wreg[jj][c][0] = w[0]; wreg[jj][c][1] = w[1]; }
    for (int ch = bx; ch < M / 64; ch += G) {
        u32x4 xrow[8][2];
#pragma unroll
        for (int t = 0; t < 8; ++t) { const u32x4* xr = (const u32x4*)((const bf16_t*)(P.ws + WS_XB) + (size_t)(ch * 64 + wave * 8 + t) * D) + lane; xrow[t][0] = xr[0]; xrow[t][1] = xr[64]; }
#pragma unroll
        for (int t = 0; t < 8; ++t) {
            const int m = ch * 64 + wave * 8 + t;
            float s = 0.f; float a[8];
#pragma unroll
            for (int e = 0; e < 8; ++e) a[e] = 0.f;
#pragma unroll
            for (int jj = 0; jj < 2; ++jj) { const u32x4 xw = xrow[t][jj]; const float xv[8] = {bf_lo(xw.x), bf_hi(xw.x), bf_lo(xw.y), bf_hi(xw.y), bf_lo(xw.z), bf_hi(xw.z), bf_lo(xw.w), bf_hi(xw.w)};
                { int w0 = 0, w1 = 0;
                  float c8[8];
#pragma unroll
                  for (int q = 0; q < 8; ++q) c8[q] = __builtin_amdgcn_fmed3f(xv[q] * X8_SCALE, -448.f, 448.f);
                  w0 = __builtin_amdgcn_cvt_pk_fp8_f32(c8[0], c8[1], w0, false); w0 = __builtin_amdgcn_cvt_pk_fp8_f32(c8[2], c8[3], w0, true);
                  w1 = __builtin_amdgcn_cvt_pk_fp8_f32(c8[4], c8[5], w1, false); w1 = __builtin_amdgcn_cvt_pk_fp8_f32(c8[6], c8[7], w1, true);
                  u32x2 w8; w8.x = (unsigned)w0; w8.y = (unsigned)w1; *((u32x2*)(P.ws + WS_XB8 + (size_t)m * D) + 64 * jj + lane) = w8; }
#pragma unroll
                for (int c = 0; c < 8; ++c) { const f32x4 w0 = wreg[jj][c][0], w1 = wreg[jj][c][1]; const float x_ = xv[c]; s += x_ * x_;
                    a[0] += x_ * w0.x; a[1] += x_ * w0.y; a[2] += x_ * w0.z; a[3] += x_ * w0.w; a[4] += x_ * w1.x; a[5] += x_ * w1.y; a[6] += x_ * w1.z; a[7] += x_ * w1.w; } }
            s = wave_sum(s);
#pragma unroll
            for (int e = 0; e < 8; ++e) a[e] = wave_sum(a[e]);
            if (lane == 0) {
                const float rs = rsqrtf(s * (1.0f / D) + EPS);
                int e1 = 0; float v1 = a[0];
#pragma unroll
                for (int e = 1; e < 8; ++e) if (a[e] > v1) { v1 = a[e]; e1 = e; }
                int e2 = -1; float v2 = -INFINITY;
#pragma unroll
                for (int e = 0; e < 8; ++e) if (e != e1 && a[e] > v2) { v2 = a[e]; e2 = e; }
                const float g1 = 1.0f / (1.0f + __expf((v2 - v1) * rs)), g2 = 1.0f - g1;
                const unsigned s1 = __hip_atomic_fetch_add(lc + e1, 1u, __ATOMIC_RELAXED, __HIP_MEMORY_SCOPE_WORKGROUP);
                const unsigned s2 = __hip_atomic_fetch_add(lc + e2, 1u, __ATOMIC_RELAXED, __HIP_MEMORY_SCOPE_WORKGROUP);
                LAS unsigned* r = rec + (wave * 8 + t) * 4;
                r[0] = (unsigned)e1 | ((unsigned)e2 << 8) | (s1 << 16) | (s2 << 24); r[1] = __builtin_bit_cast(unsigned, rs); r[2] = __builtin_bit_cast(unsigned, g1); r[3] = __builtin_bit_cast(unsigned, g2);
            }
        }
        __syncthreads();
        if (tid < 8) lc[8 + tid] = __hip_atomic_fetch_add((unsigned*)(ctl + CW_CNT + 64 * tid), lc[tid], RLX_AGENT);
        __syncthreads();
        if (tid < 64) { const LAS unsigned* r = rec + tid * 4; const unsigned ee = r[0]; const int e1 = ee & 255u, e2 = (ee >> 8) & 255u; const unsigned m = (unsigned)(ch * 64 + tid);
            const unsigned p1 = lc[8 + e1] + ((ee >> 16) & 255u), p2 = lc[8 + e2] + (ee >> 24); const float rsv = __builtin_bit_cast(float, r[1]);
            rowtok[(size_t)e1 * CAP + p1] = m; rowgate[(size_t)e1 * CAP + p1] = __builtin_bit_cast(float, r[2]); rowrs[(size_t)e1 * CAP + p1] = rsv;
            rowtok[(size_t)e2 * CAP + p2] = m | 0x80000000u; rowgate[(size_t)e2 * CAP + p2] = __builtin_bit_cast(float, r[3]); rowrs[(size_t)e2 * CAP + p2] = rsv; }
        __syncthreads();
        if (tid < 8) lc[tid] = 0u;
        __syncthreads();
    }
}
#ifndef MK_N_LAUNCHES
#define MK_N_LAUNCHES 1
#endif
constexpr int N_PHASES = 14;
constexpr int N_LAUNCHES = MK_N_LAUNCHES;
static_assert(N_LAUNCHES == 1 || N_LAUNCHES == N_PHASES, "MK_N_LAUNCHES is 1 or 14");


__global__ void __launch_bounds__(NWAVES * 64, 2) fwd(Args args) {
    extern __shared__ __attribute__((aligned(16))) unsigned char lds_raw[];
    LAS unsigned char* lds = (LAS unsigned char*)lds_raw;
    volatile LAS unsigned* MISC = (volatile LAS unsigned*)(lds + MISC_OFF);
    const int tid = threadIdx.x, lane = tid & 63, wave = __builtin_amdgcn_readfirstlane(tid >> 6);
    const int G = gridDim.x, bx = blockIdx.x;
    const int gw = bx * NWAVES + wave, NGW = G * NWAVES;
    const int vcu = (G % 8 == 0) ? (bx % 8) * (G / 8) + bx / 8 : bx;
    const Args& P = args;
    unsigned char* ws = args.ws;
    gu32* ctl = (gu32*)(ws + WS_CTL);
    if (tid < 192) MISC[tid] = 0u;
    __syncthreads();
    XcdBarrier bar; bar.bar = (unsigned*)(ctl + CW_BAR); bar.x = 0; bar.st = nullptr;
    if (N_LAUNCHES == 1) bar = xcd_barrier_post((unsigned*)(ctl + CW_BAR), MISC + 8);
#define GRID_BAR() do { if (N_LAUNCHES == 1) xcd_barrier(bar); } while (0)
    const int lo = args.ph_lo, hi = args.ph_hi;
#ifndef PH_MASK
#define PH_MASK 0x3fff
#endif
#define IN(k) ((((PH_MASK) >> (k)) & 1) && lo <= (k) && (k) < hi)
#define BOTH(k) (IN(k) && IN((k) + 1))
    bf16_t* XB = (bf16_t*)(ws + WS_XB); bf16_t* QKV = (bf16_t*)(ws + WS_QKV); bf16_t* AO = (bf16_t*)(ws + WS_AO);
    float* SS = (float*)(ws + WS_SS);
    const volatile LAS int* T = (const volatile LAS int*)(MISC + 16);

    if (IN(0)) { p0_prologue(P, lds, gw, NGW, wave, lane, G); if (BOTH(0)) GRID_BAR(); }
    if (IN(1)) {
        pg8::Gemm g{XB, (const bf16_t*)(ws + WS_WIN), D}; pg8::DenseOrder S; S.init(M, N_IN0, D, G, bx);
        if (tid < 256) ((LAS float*)(lds + GN_OFF))[tid] = P.in[3 + (tid >> 6)][tid & 63];
        pg8::EpiQKV E{QKV, N_IN0, SS, 0};
        pg8::gemm_phase(lds, g, S, E);
        if (G == 256 && bx >= 64) p0_tail_items(P, lds, P0_ITEMS - P0_DEFER + ((bx - 64) * NWAVES + wave) * 3, 3, wave, lane);
        if (BOTH(1)) GRID_BAR();
    }
    if (IN(2)) {
        attnB_run(P, lds, vcu, G, 512, wave, lane, tid);
        attnA_run<false>(P, lds, vcu, G, 1024, wave, lane, tid);
        if (BOTH(2)) GRID_BAR();
    }
    if (IN(3)) {
        attnA_run<true>(P, lds, vcu, G, 512, wave, lane, tid);
        if (BOTH(3)) GRID_BAR();
    }
    if (IN(4)) {
        pg8::Gemm g{AO, (const bf16_t*)(ws + WS_WOUT0), D}; pg8::DenseOrder S; S.init(M, D, D, G, bx);
        pg8::EpiRes E{XB, SS + (size_t)1 * M * 4, XB};
        pg8::gemm_phase(lds, g, S, E);
        if (BOTH(4)) GRID_BAR();
    }
    if (IN(5)) {
        pg8::Gemm g{XB, (const bf16_t*)(ws + WS_WGU0), D}; pg8::DenseOrder S; S.init(M, 2 * FF0, D, G, bx);
        pg8::EpiSwi<false> E{(bf16_t*)(ws + WS_H0), FF0, SS + (size_t)1 * M * 4, nullptr, T};
        pg8::gemm_phase(lds, g, S, E);
        if (G == 256 && bx >= 128) p0_tail_items(P, lds, P0_ITEMS - P0_DEFER_B + ((bx - 128) * NWAVES + wave) * 3, 3, wave, lane);
        if (BOTH(5)) GRID_BAR();
    }
    if (IN(6)) {
        pg8::Gemm g{(const bf16_t*)(ws + WS_H0), (const bf16_t*)(ws + WS_WD0), FF0}; pg8::DenseOrder S; S.init(M, D, FF0, G, bx);
        pg8::EpiRes E{XB, SS + (size_t)2 * M * 4, XB};
        pg8::gemm_phase(lds, g, S, E);
        if (BOTH(6)) GRID_BAR();
    }
    if (IN(7)) {
        pg8::Gemm g{XB, (const bf16_t*)(ws + WS_WQKV1), D}; pg8::DenseOrder S; S.init(M, N_QKV1, D, G, bx);
        if (tid < 128) ((LAS float*)(lds + GN_OFF))[tid] = P.in[15 + (tid >> 6)][tid & 63];
        pg8::EpiQKV E{QKV, N_QKV1, SS + (size_t)2 * M * 4, 1};
        pg8::gemm_phase(lds, g, S, E);
        if (BOTH(7)) GRID_BAR();
    }
    if (IN(8)) {
        for (int w = vcu; w < 256; w += G) attnC_column(P, lds, w >> 6, (w >> 2) & 15, 8 * (w & 3), 8, wave, lane, tid, G == 256 ? P0_ITEMS - P0_DEFER - P0_DEFER_C + w * 4 * P0_C_PER_WAVE : -1);
        if (BOTH(8)) GRID_BAR();
    }
    if (IN(9)) {
        pg8::Gemm g{AO, (const bf16_t*)(ws + WS_WOUT1), D}; pg8::DenseOrder S; S.init(M, D, D, G, bx);
        pg8::EpiRes E{XB, SS + (size_t)3 * M * 4, XB};
        pg8::gemm_phase(lds, g, S, E);
        if (BOTH(9)) GRID_BAR();
    }
    if (IN(10)) { route_phase(P, lds, ctl, bx, G, wave, lane, tid); if (BOTH(10)) GRID_BAR(); }
    if (IN(11) || IN(12)) {
        if (tid < 8) MISC[16 + tid] = __hip_atomic_load((unsigned*)(ctl + CW_CNT + 64 * tid), RLX_AGENT);
        __syncthreads();
        if (tid == 0) { int t0 = 0, r0 = 0, x = 0;
            for (int e = 0; e < 8; ++e) { const int c = (int)MISC[16 + e]; const int nt = (c + 255) >> 8;
                MISC[16 + e] = (unsigned)c; MISC[24 + e] = (unsigned)t0; MISC[35 + e] = (unsigned)r0; t0 += nt; r0 += nt < 16 ? nt : 16;
                for (int l = 16; l < nt; ++l) { if (x < 9) MISC[44 + x] = (unsigned)((e << 8) | l); ++x; } }
            MISC[32] = (unsigned)(t0 > MAXT ? MAXT : t0); MISC[43] = (unsigned)r0; MISC[33] = (unsigned)x;
            MISC[34] = (x >= 1 && x <= 9 && 28 * x <= G && 8 * x <= G && t0 <= MAXT) ? 1u : 0u; }
        __syncthreads();
    }
    const bool fast = T[18] != 0;
    volatile LAS unsigned* UL = (volatile LAS unsigned*)(lds + ULIST_OFF);
    LAS unsigned* TOKL = (LAS unsigned*)(lds + EPI_OFF);
    if (IN(11)) {
        pg8::Gemm g{(const bf16_t*)(ws + WS_XB8), (const bf16_t*)(ws + WS_WGUE), D / 2};
        pg8::EpiSwi<true> E{(bf16_t*)(ws + WS_HM), FFE, nullptr, (const float*)(ws + WS_ROWRS), T};
        if (fast) {
            { pg8::moe_build_list<1>(UL, T, 2 * FFE / 256, G, bx, 1, tid, (const unsigned*)(ws + WS_ROWTOK), TOKL); pg8::ListOrder S; S.init(UL, T, 2 * FFE, D / 2, 1, (const unsigned*)(ws + WS_ROWTOK), TOKL); pg8::gemm_phase(lds, g, S, E); }
            if (tid == 0) { __builtin_amdgcn_fence(__ATOMIC_RELEASE, "agent"); asm volatile("s_waitcnt vmcnt(0)" ::: "memory"); __hip_atomic_fetch_add((unsigned*)(ctl + CW_CA), 1u, RLX_AGENT); }
            if (bx < 4 * T[17]) {
                if (tid == 0) { unsigned sp = 0; while (__hip_atomic_load((unsigned*)(ctl + CW_CA), RLX_AGENT) < (unsigned)G && ++sp < (1u << 22)) __builtin_amdgcn_s_sleep(2);
                    __builtin_amdgcn_fence(__ATOMIC_ACQUIRE, "agent"); asm volatile("s_waitcnt vmcnt(0)" ::: "memory"); }
                __syncthreads();
                pg8::Gemm gd{(const bf16_t*)(ws + WS_HM), (const bf16_t*)(ws + WS_WDE), FFE / 2}; pg8::moe_build_list<3>(UL, T, D / 256, G, bx, 1, tid, nullptr, TOKL); pg8::ListOrder Sd; Sd.init(UL, T, D, FFE / 2, 0, nullptr, TOKL);
                pg8::EpiMoeDown Ed{(bf16_t*)(ws + WS_Y1), (bf16_t*)(ws + WS_Y2), (bf16_t*)(ws + WS_Y2X), (const unsigned*)(ws + WS_ROWTOK), (const float*)(ws + WS_ROWGATE), T};
                pg8::gemm_phase(lds, gd, Sd, Ed);
            }
        }
        { pg8::moe_build_list<2>(UL, T, 2 * FFE / 256, G, bx, fast ? 1 : 0, tid, (const unsigned*)(ws + WS_ROWTOK), TOKL); pg8::ListOrder S; S.init(UL, T, 2 * FFE, D / 2, 1, (const unsigned*)(ws + WS_ROWTOK), TOKL); pg8::gemm_phase(lds, g, S, E); }
        if (BOTH(11)) GRID_BAR();
    }
    if (IN(12)) {
        if (fast) {
            const int nrows = T[17] * 256; const unsigned* rowtok = (const unsigned*)(ws + WS_ROWTOK);
            for (int rr = gw; rr < nrows; rr += NGW) { const int k = rr >> 8, r = rr & 255, w = T[28 + k], e = w >> 8, idx = (w & 255) * 256 + r;
                if (idx < T[e]) { const unsigned tk = rowtok[(size_t)e * CAP + idx];
                    const u32x4* src = (const u32x4*)((const bf16_t*)(ws + WS_Y2X) + (size_t)rr * D); u32x4* dst = (u32x4*)((bf16_t*)(ws + ((tk >> 31) ? WS_Y2 : WS_Y1)) + (size_t)(tk & 0x7fffffffu) * D);
                    dst[lane] = src[lane]; dst[64 + lane] = src[64 + lane]; } }
        }
        pg8::Gemm g{(const bf16_t*)(ws + WS_HM), (const bf16_t*)(ws + WS_WDE), FFE / 2}; pg8::moe_build_list<4>(UL, T, D / 256, G, bx, fast ? 1 : 0, tid, nullptr, TOKL); pg8::ListOrder S; S.init(UL, T, D, FFE / 2, 0, nullptr, TOKL);
        pg8::EpiMoeDown E{(bf16_t*)(ws + WS_Y1), (bf16_t*)(ws + WS_Y2), (bf16_t*)(ws + WS_Y2X), (const unsigned*)(ws + WS_ROWTOK), (const float*)(ws + WS_ROWGATE), T};
        pg8::gemm_phase(lds, g, S, E);
        if (BOTH(12)) GRID_BAR();
    }
    if (IN(13)) {
        const bf16_t* y1 = (const bf16_t*)(ws + WS_Y1); const bf16_t* y2 = (const bf16_t*)(ws + WS_Y2);
        for (size_t i = ((size_t)bx * (NWAVES * 64) + tid) * 8; i < (size_t)M * D; i += (size_t)G * (NWAVES * 64) * 8) {
            const u32x4 x = __builtin_nontemporal_load((const u32x4*)(XB + i)), p = __builtin_nontemporal_load((const u32x4*)(y1 + i)), q = __builtin_nontemporal_load((const u32x4*)(y2 + i));
            const f32x4 a = (f32x4){bf_lo(x.x) + bf_lo(p.x) + bf_lo(q.x), bf_hi(x.x) + bf_hi(p.x) + bf_hi(q.x), bf_lo(x.y) + bf_lo(p.y) + bf_lo(q.y), bf_hi(x.y) + bf_hi(p.y) + bf_hi(q.y)};
            const f32x4 b = (f32x4){bf_lo(x.z) + bf_lo(p.z) + bf_lo(q.z), bf_hi(x.z) + bf_hi(p.z) + bf_hi(q.z), bf_lo(x.w) + bf_lo(p.w) + bf_lo(q.w), bf_hi(x.w) + bf_hi(p.w) + bf_hi(q.w)};
            __builtin_nontemporal_store(a, (f32x4*)(P.out + i)); __builtin_nontemporal_store(b, (f32x4*)(P.out + i + 4)); }
    }
#undef IN
#undef BOTH
#undef GRID_BAR
}

extern "C" void kernel_launch(void* const* d_in, const int* in_sizes, int n_in, void* d_out, int out_size, void* d_ws, size_t ws_size, hipStream_t stream) {
    static int grid = 0;
    if (grid == 0) {
        if (n_in != 24 || in_sizes[0] != M * D || out_size != M * D || ws_size < WS_END) { fprintf(stderr, "kernel_launch: unexpected shapes (n_in %d, in0 %d, out %d, ws %zu < %zu); nothing launched\n", n_in, n_in > 0 ? in_sizes[0] : -1, out_size, ws_size, (size_t)WS_END); grid = -1; return; }
        int dev = 0, cus = 0, per_cu = 0;
        if (hipGetDevice(&dev) != hipSuccess || hipDeviceGetAttribute(&cus, hipDeviceAttributeMultiprocessorCount, dev) != hipSuccess) { fprintf(stderr, "kernel_launch: device query failed\n"); grid = -1; return; }
        if (hipFuncSetAttribute((const void*)fwd, hipFuncAttributeMaxDynamicSharedMemorySize, LDS_BYTES) != hipSuccess) { fprintf(stderr, "kernel_launch: hipFuncSetAttribute(%d B LDS) failed\n", LDS_BYTES); grid = -1; return; }
        if (hipOccupancyMaxActiveBlocksPerMultiprocessor(&per_cu, (const void*)fwd, NWAVES * 64, LDS_BYTES) != hipSuccess || per_cu < 1) { fprintf(stderr, "kernel_launch: occupancy query reports %d workgroups per CU\n", per_cu); }
        (void)hipGetLastError();
        grid = cus;
    }
    if (grid < 0) return;
    if (hipMemsetAsync((char*)d_ws + WS_CTL, 0, CTL_ZERO_BYTES, stream) != hipSuccess) { fprintf(stderr, "kernel_launch: memset failed\n"); return; }
    Args a{};
    for (int i = 0; i < 24; ++i) a.in[i] = (const float*)d_in[i];
    a.out = (float*)d_out; a.ws = (unsigned char*)d_ws;
    for (int li = 0; li < N_LAUNCHES; ++li) {
        a.ph_lo = (N_LAUNCHES == 1) ? 0 : li; a.ph_hi = (N_LAUNCHES == 1) ? N_PHASES : li + 1; a.li = li; a.pad = 0;
        hipLaunchKernelGGL(fwd, dim3(grid), dim3(NWAVES * 64), LDS_BYTES, stream, a);
        const hipError_t le = hipPeekAtLastError();
        if (le != hipSuccess) { fprintf(stderr, "kernel_launch: launch %d failed: %s\n", li, hipGetErrorName(le)); break; }
    }
}
```

```cpp
#include <hip/hip_runtime.h>
#include <cstdio>
#include <cstdint>
#include <cmath>

#define LAS __attribute__((address_space(3)))
#define GAS __attribute__((address_space(1)))
typedef unsigned short bf16_t;
typedef short bf16x8 __attribute__((ext_vector_type(8)));
typedef short s16x4 __attribute__((ext_vector_type(4)));
typedef float f32x4 __attribute__((ext_vector_type(4)));
typedef float f32x2 __attribute__((ext_vector_type(2)));
typedef float f32x16 __attribute__((ext_vector_type(16)));
typedef unsigned u32x4 __attribute__((ext_vector_type(4)));
typedef unsigned u32x2 __attribute__((ext_vector_type(2)));
typedef GAS unsigned gu32;
#define RLX_AGENT __ATOMIC_RELAXED, __HIP_MEMORY_SCOPE_AGENT
#define LDS_WAIT() asm volatile("s_waitcnt lgkmcnt(0)" ::: "memory")
#define VM_WAIT() asm volatile("s_waitcnt vmcnt(0)" ::: "memory")

constexpr int D = 1024, SEQ = 4096, NB = 4, M = NB * SEQ, HD = 64;
constexpr int N_IN0 = 2304, FF0 = 2816, N_QKV1 = 3072, NE = 8, FFE = 3584;
constexpr float EPS = 1e-6f, LOG2E = 1.4426950408889634f, C2 = 0.125f * LOG2E;
constexpr float W8_SCALE = 32.f, X8_SCALE = 16.f, H8_SCALE = 4.f, Y8_SCALE = 64.f;
constexpr int CAP = 16384;
constexpr int MAXT = 136;

constexpr size_t MiB = 1u << 20;
constexpr size_t WS_CTL = 0, CTL_ZERO_BYTES = 32 * 1024;
constexpr size_t WS_ROWTOK = 1 * MiB;
constexpr size_t WS_ROWGATE = 2 * MiB;
constexpr size_t WS_ROWRS = 2 * MiB + 512 * 1024;
constexpr size_t WS_SS = 3 * MiB;
constexpr size_t WS_XB = 4 * MiB;
constexpr size_t WS_WGUE = 36 * MiB;
constexpr size_t WS_XB8 = 92 * MiB;
constexpr size_t WS_Y2 = 36 * MiB;
constexpr size_t WS_Y1 = 68 * MiB;
constexpr size_t WS_WDE = 148 * MiB;
constexpr size_t WS_BIG = 204 * MiB;
constexpr size_t WS_HM = WS_BIG;
constexpr size_t WS_QKV = WS_BIG;
constexpr size_t WS_H0 = WS_BIG;
constexpr size_t WS_AO = WS_BIG + 96 * MiB;
constexpr size_t WS_WIN = WS_BIG + 128 * MiB;
constexpr size_t WS_WOUT0 = WS_WIN + 4608 * 1024;
constexpr size_t WS_WGU0 = WS_WOUT0 + 2 * MiB;
constexpr size_t WS_WD0 = WS_WGU0 + 11 * MiB;
constexpr size_t WS_WQKV1 = WS_WD0 + 5632 * 1024;
constexpr size_t WS_WOUT1 = WS_WQKV1 + 6 * MiB;
constexpr size_t WS_PA1 = WS_WOUT1 + 2 * MiB;
constexpr size_t WS_PA4 = WS_PA1 + 16 * MiB;
constexpr size_t WS_LSE = WS_PA4 + 16 * MiB;
constexpr size_t WS_Y2X = WS_BIG + 238 * MiB;
constexpr size_t WS_END = WS_Y2X + 9 * 256 * 2048;
static_assert(WS_LSE + 2 * (size_t)M * 8 * 4 <= WS_END, "d_ws map");
static_assert((size_t)MAXT * 256 * FFE * 2 <= 238 * MiB, "HM fits");
constexpr int CW_CNT = 64;
constexpr int CW_CA = 1024;
constexpr int CW_BAR = 4096;

constexpr int RING_BYTES = 147456;
constexpr int EPI_OFF = 131072;
constexpr int RPB_OFF = 147456;
constexpr int MISC_OFF = 151552;
constexpr int ULIST_OFF = MISC_OFF + 256;
constexpr int OSTAGE_OFF = ULIST_OFF + 512;
constexpr int RS_OFF = OSTAGE_OFF + 8192;
constexpr int GN_OFF = RS_OFF + 2048;
constexpr int LDS_BYTES = GN_OFF + 1024;

__device__ __forceinline__ unsigned f2bf(float f) { unsigned u = __builtin_bit_cast(unsigned, f); return (u + 0x7fffu + ((u >> 16) & 1u)) >> 16; }
__device__ __forceinline__ unsigned pk2(float lo, float hi) { return f2bf(lo) | (f2bf(hi) << 16); }
__device__ __forceinline__ unsigned cvt_pk_bf16(float lo, float hi) { unsigned r; asm volatile("v_cvt_pk_bf16_f32 %0, %1, %2" : "=v"(r) : "v"(lo), "v"(hi)); return r; }
__device__ __forceinline__ unsigned cvt_pk4_fp8(float a, float b, float c, float d) { unsigned r;
    asm volatile("v_med3_f32 %1, %1, -%5, %5\n\tv_med3_f32 %2, %2, -%5, %5\n\tv_med3_f32 %3, %3, -%5, %5\n\tv_med3_f32 %4, %4, -%5, %5\n\tv_cvt_pk_fp8_f32 %0, %1, %2\n\tv_cvt_pk_fp8_f32 %0, %3, %4 op_sel:[0,0,1]"
                 : "=&v"(r), "+v"(a), "+v"(b), "+v"(c), "+v"(d) : "s"(448.f)); return r; }
__device__ __forceinline__ float bf_lo(unsigned w) { return __builtin_bit_cast(float, w << 16); }
__device__ __forceinline__ float bf_hi(unsigned w) { return __builtin_bit_cast(float, w & 0xffff0000u); }
__device__ __forceinline__ float wave_sum(float v) {
#pragma unroll
    for (int o = 1; o < 64; o <<= 1) v += __shfl_xor(v, o);
    return v;
}
__device__ __forceinline__ float xor16_sum(float v) { float a = v, b = v; asm volatile("s_nop 1\n\tv_permlane16_swap_b32 %0, %1\n\ts_nop 1" : "+v"(a), "+v"(b)); return a + b; }
__device__ __forceinline__ float xor32_sum(float v) { float a = v, b = v; asm volatile("s_nop 1\n\tv_permlane32_swap_b32 %0, %1\n\ts_nop 1" : "+v"(a), "+v"(b)); return a + b; }
__device__ __forceinline__ float rstd_of(const float* ss, int row) { const f32x4 v = *(const f32x4*)(ss + (size_t)row * 4); return rsqrtf(((v.x + v.y) + (v.z + v.w)) * (1.0f / D) + EPS); }
namespace pg8 {
constexpr int BM = 256, BK = 64, HALF = 128, HTB = HALF * BK * 2  , STAGE_BYTES = 8 * HTB, NXCD = 8, WGM = 8;
__host__ __device__ __forceinline__ int lds_byte(int r, int c) { const int st = (r >> 4) * 2 + (c >> 5), rr = r & 15, cc = c & 31, ob = rr * 64 + cc * 2; return st * 1024 + (ob ^ (((ob >> 9) & 1) << 5)); }
__host__ __device__ __forceinline__ void stage_rc(int b, int& R, int& C) { const int st = b / 1024, sb = b % 1024, swz = sb ^ (((sb >> 9) & 1) << 5); R = (st >> 1) * 16 + swz / 64; C = (st & 1) * 32 + (swz % 64) / 2; }
__host__ __device__ __forceinline__ int gray4(int g) { return g ^ (g >> 1); }
__host__ __device__ __forceinline__ int lds_byte8(int r, int c) { const int st = (r >> 4) * 2 + (c >> 5), rr = r & 15, ch = (c >> 3) & 3; return st * 1024 + rr * 64 + ((ch ^ gray4(rr >> 2)) << 4); }
__host__ __device__ __forceinline__ void stage_rc8(int b, int& R, int& C) { const int st = b / 1024, sb = b % 1024, rr = sb / 64, ch = ((sb % 64) / 16) ^ gray4(rr >> 2); R = (st >> 1) * 16 + rr; C = (st & 1) * 32 + ch * 8; }
__host__ __device__ __forceinline__ int perm32(int rho) { const int n = rho >> 4, i = rho & 15; return 8 * (i >> 2) + 4 * n + (i & 3); }

struct Unit { int pm, pn, e, lt, aux, li; };
struct Gemm { const bf16_t* A; const bf16_t* Bt; int K; };

__device__ __forceinline__ void map_unit(int L, int nM, int nN, int nwg, int& pm, int& pn) {
    int wgid = L; { const int q = nwg / NXCD, r = nwg % NXCD, xcd = wgid % NXCD, off = wgid / NXCD; wgid = (xcd < r ? xcd * (q + 1) : r * (q + 1) + (xcd - r) * q) + off; }
    const int nig = WGM * nN, gid = wgid / nig, fm = gid * WGM, gsz = (nM - fm) < WGM ? (nM - fm) : WGM;
    pm = fm + ((wgid % nig) % gsz); pn = (wgid % nig) / gsz;
}
struct DenseOrder {
    int nM, nN, nwg, G, c, K;
    __device__ __forceinline__ void init(int M_, int N_, int K_, int G_, int c_) { nM = M_ / BM; nN = N_ / BM; nwg = nM * nN; G = G_; c = c_; K = K_; }
    __device__ __forceinline__ bool next(int i, Unit& u) const { const long L = (long)i * G + c; if (L >= nwg) return false; map_unit((int)L, nM, nN, nwg, u.pm, u.pn); u.e = 0; u.lt = 0; u.aux = -1; u.li = i; return true; }
    __device__ __forceinline__ unsigned arow(const Unit& u, int r) const { return (unsigned)(u.pm * BM + r); }
    __device__ __forceinline__ size_t boff(const Unit& u) const { return (size_t)u.pn * BM * K * 2; }
};
template <int KIND>
__device__ __forceinline__ void moe_build_list(volatile LAS unsigned* UL, const volatile LAS int* T, int nN, int G, int c, int fast, int tid, const unsigned* rowtok, LAS unsigned* TOKL) {
    if (tid < 64) {
        const int i = tid; int e = 0, lt = 0, pn = 0, aux = -1; bool ok = true;
        const bool all = (KIND == 2 || KIND == 4) && !fast;
        if (all) { const int NT = T[16]; const long L = (long)i * G + c; const int nwg = NT * nN; ok = L < nwg;
            if (ok) { int vt; map_unit((int)L, NT, nN, nwg, vt, pn); int ee = 0; for (int k = 1; k < 8; ++k) ee += (vt >= T[8 + k]) ? 1 : 0; e = ee; lt = vt - T[8 + ee]; } }
        else if (KIND == 3) { ok = i == 0; const int w = T[28 + (c >> 2)]; e = w >> 8; lt = w & 255; pn = c & 3; aux = c >> 2; }
        else {
            long q; const int X = T[17], R = T[27]; int ncol = nN;
            if (KIND == 4) { q = (long)i * G + c; }
            else {
                long L;
                if (KIND == 1) { ok = i == 0; L = c; }
                else { const int NO = 4 * X; const int s = (c < NO) ? i + 5 : i + 1; L = (s <= 4) ? (long)G + (long)(s - 1) * (G - NO) + (c - NO) : (long)G + 4L * (G - NO) + (long)(s - 5) * G + c; }
                const int nx = ncol * X;
                if (L < nx) { const int k = (int)L / ncol; const int w = T[28 + k]; e = w >> 8; lt = w & 255; pn = (int)L % ncol; aux = k; q = -1; }
                else q = L - nx;
            }
            if (q >= 0) { const int nwg = ncol * R; ok = ok && q < nwg;
                if (ok) { int r; map_unit((int)q, R, ncol, nwg, r, pn); int ee = 0; for (int k = 1; k < 8; ++k) ee += (r >= T[19 + k]) ? 1 : 0; e = ee; lt = r - T[19 + ee]; } }
        }
        const int pm = T[8 + e] + lt;
        UL[2 * i] = (unsigned)pm | ((unsigned)pn << 16);
        UL[2 * i + 1] = (unsigned)e | ((unsigned)lt << 8) | ((unsigned)(aux + 1) << 16) | (ok ? 0x80000000u : 0u);
    }
    __syncthreads();
    if (rowtok) {
        unsigned tokv[8];
#pragma unroll
        for (int k = 0; k < 8; ++k) { const int idx = tid + 512 * k, i = idx >> 8, r = idx & 255; const unsigned w1 = UL[2 * i + 1]; tokv[k] = 0u;
            if (w1 >> 31) { const int e = (int)(w1 & 255u), p = (int)((w1 >> 8) & 255u) * BM + r; if (p < T[e]) tokv[k] = rowtok[(size_t)e * CAP + p] & 0x7fffffffu; } }
#pragma unroll
        for (int k = 0; k < 8; ++k) TOKL[tid + 512 * k] = tokv[k];
        __syncthreads();
    }
}
struct ListOrder {
    int K, Nexp, gather; const volatile LAS unsigned* UL; const volatile LAS int* T; const unsigned* rowtok; const LAS unsigned* TOKL;
    __device__ __forceinline__ void init(const volatile LAS unsigned* UL_, const volatile LAS int* T_, int N_, int K_, int gather_, const unsigned* rowtok_, const LAS unsigned* TOKL_) { UL = UL_; T = T_; K = K_; Nexp = N_; gather = gather_; rowtok = rowtok_; TOKL = TOKL_; }
    __device__ __forceinline__ bool next(int i, Unit& u) const {
        const int ii = i < 63 ? i : 63; const unsigned w0 = UL[2 * ii], w1 = UL[2 * ii + 1];
        u.pm = (int)(w0 & 0xffffu); u.pn = (int)(w0 >> 16); u.e = (int)(w1 & 255u); u.lt = (int)((w1 >> 8) & 255u); u.aux = (int)((w1 >> 16) & 255u) - 1; u.li = i;
        return i < 64 && (w1 >> 31) != 0u; }
    __device__ __forceinline__ unsigned arow(const Unit& u, int r) const {
        if (!gather) return (unsigned)(u.pm * BM + r);
        if (u.li < 16) return TOKL[u.li * BM + r];
        const int idx = u.lt * BM + r; const int cnt = T[u.e];
        return idx < cnt ? (rowtok[(size_t)u.e * CAP + idx] & 0x7fffffffu) : 0u; }
    __device__ __forceinline__ size_t boff(const Unit& u) const { return ((size_t)u.e * Nexp + (size_t)u.pn * BM) * K * 2; }
};

typedef int i32x8 __attribute__((ext_vector_type(8)));
typedef int i32x4 __attribute__((ext_vector_type(4)));
#define pg8_cat(lo, hi) __builtin_shufflevector(lo, hi, 0, 1, 2, 3, 4, 5, 6, 7)
typedef f32x16 AccT[2][2][2];
#define PG8_AG(A_, ai, bj, m, n) ((f32x4){A_[ai][bj][(m) >> 1][(((m) & 1) * 2 + (n)) * 4 + 0], A_[ai][bj][(m) >> 1][(((m) & 1) * 2 + (n)) * 4 + 1], A_[ai][bj][(m) >> 1][(((m) & 1) * 2 + (n)) * 4 + 2], A_[ai][bj][(m) >> 1][(((m) & 1) * 2 + (n)) * 4 + 3]})
#define PG8_AS(A_, ai, bj, m, n, v_) do { A_[ai][bj][(m) >> 1][(((m) & 1) * 2 + (n)) * 4 + 0] = (v_)[0]; A_[ai][bj][(m) >> 1][(((m) & 1) * 2 + (n)) * 4 + 1] = (v_)[1]; A_[ai][bj][(m) >> 1][(((m) & 1) * 2 + (n)) * 4 + 2] = (v_)[2]; A_[ai][bj][(m) >> 1][(((m) & 1) * 2 + (n)) * 4 + 3] = (v_)[3]; } while (0)
#define PG8_ZERO(A_) do { u32x4 zq_ = {0u, 0u, 0u, 0u}; const f32x16 z16_ = {0.f, 0.f, 0.f, 0.f, 0.f, 0.f, 0.f, 0.f, 0.f, 0.f, 0.f, 0.f, 0.f, 0.f, 0.f, 0.f}; \
        _Pragma("unroll") for (int a_ = 0; a_ < 2; ++a_) _Pragma("unroll") for (int b_ = 0; b_ < 2; ++b_) _Pragma("unroll") for (int m_ = 0; m_ < 2; ++m_) \
        { asm volatile("" : "+v"(zq_)); const bf16x8 zz_ = __builtin_bit_cast(bf16x8, zq_); A_[a_][b_][m_] = __builtin_amdgcn_mfma_f32_32x32x16_bf16(zz_, zz_, z16_, 0, 0, 0); } } while (0)
template <class Epi, class Sched>
__device__ __forceinline__ void gemm_phase(LAS unsigned char* lds, const Gemm g, const Sched& S, const Epi& E) {
    int tid_ = threadIdx.x; asm volatile("" : "+v"(tid_));
    const int tid = tid_, wid = __builtin_amdgcn_readfirstlane(tid >> 6), lane = tid & 63, wr = wid >> 2, wc = wid & 3, fr = lane & 15, fq = lane >> 4;
    const int K = g.K, nt = K / BK;
    unsigned voffB0; unsigned ca0;
    { int R, C; if (Epi::FP8) stage_rc8(tid * 16, R, C); else stage_rc(tid * 16, R, C);
      const int Rb = Epi::BMODE == 0 ? R : (Epi::BMODE == 1 ? ((R & ~31) + perm32(R & 31)) : (64 * (R >> 5) + perm32(R & 31)));
      voffB0 = (unsigned)(Rb * K + C) * 2u; ca0 = (unsigned)C * 2u; }
    const unsigned dB1 = (unsigned)((Epi::BMODE == 2 ? 128 : 64) * K) * 2u;
    const size_t kstep = (size_t)(BK * 2);
    const size_t hstepB = (size_t)(Epi::BMODE == 2 ? 32 : HALF) * K * 2;
    const unsigned rowb = (unsigned)K * 2u;
    const unsigned ldsw = (unsigned)wid * 1024u;
    const int aoff = Epi::FP8 ? lds_byte8(wr * 64 + fr, fq * 16) : lds_byte(wr * 64 + fr, fq * 8), boff = Epi::FP8 ? lds_byte8(wc * 32 + fr, fq * 16) : lds_byte(wc * 32 + fr, fq * 8);
    const char* const Ab = (const char*)g.A;
#define PG8_SA(b, h) (((b) * 2 + (h)) * HTB)
#define PG8_SB(b, h) ((4 + (b) * 2 + (h)) * HTB)
#define PG8_STG(bufoff, p0, p1, aux) do { \
        __builtin_amdgcn_global_load_lds((const unsigned*)(p0), (LAS unsigned*)(lds + (bufoff) + ldsw), 16, 0, aux); \
        __builtin_amdgcn_global_load_lds((const unsigned*)(p1), (LAS unsigned*)(lds + (bufoff) + ldsw + 8192), 16, 0, aux); } while (0)
#define PG8_STAGEB(bufoff, gbase) PG8_STG(bufoff, (const char*)(gbase) + voffB0, (const char*)(gbase) + voffB0 + dB1, 0)
#define PG8_STAGEA(bufoff, kb, rp) PG8_STG(bufoff, Ab + (kb) + (((rp) & 0xffffu) * rowb + ca0), Ab + (kb) + (((rp) >> 16) * rowb + ca0), Epi::A_AUX)
#define PG8_LDA(dst, b, h) do { if constexpr (Epi::FP8) { _Pragma("unroll") for (int m = 0; m < 4; ++m) dst##8[m] = pg8_cat(*(const LAS i32x4*)(lds + PG8_SA(b, h) + aoff + m * 2048), *(const LAS i32x4*)(lds + PG8_SA(b, h) + (aoff ^ 16) + m * 2048)); } \
        else { _Pragma("unroll") for (int m = 0; m < 4; ++m) _Pragma("unroll") for (int k = 0; k < 2; ++k) dst[m][k] = *(const LAS i32x4*)(lds + PG8_SA(b, h) + aoff + m * 2048 + k * 1024); } } while (0)
#define PG8_LDB(dst, b, h) do { if constexpr (Epi::FP8) { _Pragma("unroll") for (int n = 0; n < 2; ++n) dst##8[n] = pg8_cat(*(const LAS i32x4*)(lds + PG8_SB(b, h) + boff + n * 2048), *(const LAS i32x4*)(lds + PG8_SB(b, h) + (boff ^ 16) + n * 2048)); } \
        else { _Pragma("unroll") for (int n = 0; n < 2; ++n) _Pragma("unroll") for (int k = 0; k < 2; ++k) dst[n][k] = *(const LAS i32x4*)(lds + PG8_SB(b, h) + boff + n * 2048 + k * 1024); } } while (0)
#define PG8_MMA(ai, bj, At, Bt) do { __builtin_amdgcn_s_setprio(1); \
        if constexpr (Epi::FP8) { _Pragma("unroll") for (int m = 0; m < 4; ++m) _Pragma("unroll") for (int n = 0; n < 2; ++n) \
            { const f32x4 r_ = __builtin_amdgcn_mfma_scale_f32_16x16x128_f8f6f4(Bt##8[n], At##8[m], PG8_AG(acc, ai, bj, m, n), 0, 0, 0, 127, 0, 127); PG8_AS(acc, ai, bj, m, n, r_); } } \
        else { _Pragma("unroll") for (int m = 0; m < 4; ++m) _Pragma("unroll") for (int n = 0; n < 2; ++n) _Pragma("unroll") for (int k = 0; k < 2; ++k) \
            { const f32x4 r_ = __builtin_amdgcn_mfma_f32_16x16x32_bf16(__builtin_bit_cast(bf16x8, Bt[n][k]), __builtin_bit_cast(bf16x8, At[m][k]), PG8_AG(acc, ai, bj, m, n), 0, 0, 0); PG8_AS(acc, ai, bj, m, n, r_); } } \
        __builtin_amdgcn_s_setprio(0); } while (0)
#define PG8_WAIT_V(n) asm volatile("s_waitcnt vmcnt(" #n ")" ::: "memory")
#define PG8_WAIT_L(n) asm volatile("s_waitcnt lgkmcnt(" #n ")" ::: "memory")
#define PG8_BAR __builtin_amdgcn_s_barrier()
#define PG8_SCHED __builtin_amdgcn_sched_barrier(0)
#define PG8_ROWS(dst, u) do { int t2_ = tid; asm volatile("" : "+v"(t2_)); int R_, C_; if (Epi::FP8) stage_rc8(t2_ * 16, R_, C_); else stage_rc(t2_ * 16, R_, C_); \
        _Pragma("unroll") for (int h = 0; h < 2; ++h) dst[h] = S.arow(u, h * HALF + R_) | (S.arow(u, h * HALF + R_ + 64) << 16); } while (0)
    Unit cur, nxt; int ui = 0;
    if (!S.next(0, cur)) return;
    AccT acc;
#pragma unroll
    for (int a = 0; a < 2; ++a)
#pragma unroll
        for (int b = 0; b < 2; ++b)
#pragma unroll
            for (int m = 0; m < 2; ++m)
#pragma unroll
                for (int q = 0; q < 16; ++q) acc[a][b][m][q] = 0.f;
    i32x4 At[4][2], B0[2][2], B1[2][2]; i32x8 At8[4], B08[2], B18[2];
    unsigned rc[2], rn[2];
    PG8_ROWS(rc, cur);
    E.pre_store(E.pre_load(cur, tid), 0, lds, tid);
    const char* cB = (const char*)g.Bt + S.boff(cur);
    PG8_STAGEB(PG8_SB(0, 0), cB); PG8_STAGEB(PG8_SB(0, 1), cB + hstepB); PG8_STAGEA(PG8_SA(0, 0), 0, rc[0]); PG8_STAGEA(PG8_SA(0, 1), 0, rc[1]);
    if (wr == 1) PG8_BAR;
    PG8_WAIT_V(2); PG8_BAR;
    PG8_STAGEB(PG8_SB(1, 0), cB + kstep); PG8_STAGEA(PG8_SA(1, 0), kstep, rc[0]); PG8_STAGEB(PG8_SB(1, 1), cB + hstepB + kstep);
    PG8_WAIT_V(6); PG8_BAR;
    for (;;) {
        const bool has_next = S.next(ui + 1, nxt);
        if (has_next) { PG8_ROWS(rn, nxt); } else { rn[0] = rc[0]; rn[1] = rc[1]; }
        const char* nB = has_next ? (const char*)g.Bt + S.boff(nxt) : cB;
#pragma unroll 1
        for (int t = 0; t < nt; t += 2) {
            const bool last = (t == nt - 2);
            const size_t k1 = (size_t)(t + 1) * kstep;
            const size_t k2 = last ? (size_t)0 : (size_t)(t + 2) * kstep, k3 = k2 + kstep;
            const char* b2 = last ? nB : cB + (size_t)(t + 2) * kstep; const char* b3 = b2 + kstep;
            const unsigned ra0 = last ? rn[0] : rc[0], ra1 = last ? rn[1] : rc[1];
            PG8_LDB(B0, 0, 0); PG8_LDB(B1, 0, 1); PG8_SCHED; PG8_LDA(At, 0, 0); PG8_STAGEA(PG8_SA(1, 1), k1, rc[1]);
            PG8_WAIT_V(8); PG8_WAIT_L(0); PG8_BAR; PG8_MMA(0, 0, At, B0); PG8_MMA(0, 1, At, B1); PG8_BAR; PG8_SCHED;
            PG8_LDA(At, 0, 1); PG8_STAGEB(PG8_SB(0, 0), b2); PG8_STAGEB(PG8_SB(0, 1), b2 + hstepB); PG8_STAGEA(PG8_SA(0, 0), k2, ra0);
            PG8_WAIT_V(8); PG8_WAIT_L(0); PG8_BAR; PG8_MMA(1, 0, At, B0); PG8_MMA(1, 1, At, B1); PG8_BAR; PG8_SCHED;
            PG8_LDB(B0, 1, 0); PG8_LDB(B1, 1, 1); PG8_SCHED; PG8_LDA(At, 1, 0); PG8_STAGEA(PG8_SA(0, 1), k2, ra1);
            PG8_WAIT_V(8); PG8_WAIT_L(0); PG8_BAR; PG8_MMA(0, 0, At, B0); PG8_MMA(0, 1, At, B1); PG8_BAR; PG8_SCHED;
            PG8_LDA(At, 1, 1); PG8_STAGEB(PG8_SB(1, 0), b3); PG8_STAGEB(PG8_SB(1, 1), b3 + hstepB); PG8_STAGEA(PG8_SA(1, 0), k3, ra0);
            PG8_WAIT_V(8); PG8_WAIT_L(0); PG8_BAR; PG8_MMA(1, 0, At, B0); PG8_MMA(1, 1, At, B1); PG8_BAR; PG8_SCHED;
        }
        if (Epi::ALIGN) { if (wr == 0) PG8_BAR; }
        const float nrs = has_next ? E.pre_load(nxt, tid) : 0.f;
        E(acc, cur, wr, wc, fr, fq, lds, tid, ui & 1);
        if (!has_next) break;
        E.pre_store(nrs, (ui + 1) & 1, lds, tid);
        PG8_ZERO(acc);
        cur = nxt; cB = nB; ++ui;
        rc[0] = rn[0]; rc[1] = rn[1];
        if (Epi::ALIGN) { if (wr == 1) PG8_BAR; }
    }
    PG8_WAIT_V(0);
    if (!Epi::ALIGN) { if (wr == 0) PG8_BAR; }
    PG8_BAR;
#undef PG8_SA
#undef PG8_SB
#undef PG8_STG
#undef PG8_STAGEA
#undef PG8_STAGEB
#undef PG8_LDA
#undef PG8_LDB
#undef PG8_MMA
#undef PG8_WAIT_V
#undef PG8_WAIT_L
#undef PG8_BAR
#undef PG8_SCHED
#undef PG8_ROWS
}
}
namespace pg8 {
struct EpiQKV {
    static constexpr int BMODE = 2, A_AUX = 0; static constexpr bool ALIGN = true, FP8 = false; static constexpr int NST = 16;
    bf16_t* O; int ldc; const float* ss; int layer;
    __device__ __forceinline__ float pre_load(const Unit& u, int tid) const { return tid < 256 ? rstd_of(ss, u.pm * BM + tid) : 0.f; }
    __device__ __forceinline__ void pre_store(float v, int buf, LAS unsigned char* lds, int tid) const { if (tid < 256) ((LAS float*)(lds + RS_OFF))[buf * 256 + tid] = v; }
    __device__ __forceinline__ void operator()(const AccT& acc, const Unit& u, int wr, int wc, int fr, int fq, LAS unsigned char* lds, int, int buf) const {
        int kind = 0, gi = 0;
        if (layer == 0) {
            if (u.pn < 2) { kind = 1; gi = 0; } else if (u.pn < 4) { kind = 2; gi = 1; } else if (u.pn < 6) { kind = 0; }
            else if (u.pn < 8) { kind = 1; gi = 2; } else { if (wc < 2) { kind = 2; gi = 3; } }
        } else { if (u.pn < 4) { kind = 1; gi = 0; } else if (u.pn < 8) { kind = 2; gi = 1; } }
        const LAS float* g = (const LAS float*)(lds + GN_OFF) + gi * 64; const LAS float* RS = (const LAS float*)(lds + RS_OFF) + buf * 256;
        f32x4 gv[2][2];
#pragma unroll
        for (int bj = 0; bj < 2; ++bj)
#pragma unroll
            for (int n = 0; n < 2; ++n) gv[bj][n] = kind ? *(const LAS f32x4*)(g + 32 * bj + 8 * fq + 4 * n) : (f32x4){1.f, 1.f, 1.f, 1.f};
        const float post = kind == 1 ? C2 : 1.f;
        bf16_t* slotp = O + (size_t)(4 * u.pn + wc) * M * 64 + 8 * fq;
        float rsv[2][4];
#pragma unroll
        for (int ai = 0; ai < 2; ++ai)
#pragma unroll
            for (int m = 0; m < 4; ++m) rsv[ai][m] = RS[ai * HALF + wr * 64 + m * 16 + fr];
#pragma unroll
        for (int ai = 0; ai < 2; ++ai)
#pragma unroll
            for (int m = 0; m < 4; ++m) {
                const int row = u.pm * BM + ai * HALF + wr * 64 + m * 16 + fr;
                const float rs = rsv[ai][m];
                float sc = rs;
                if (kind) {
                    float q = 0.f;
#pragma unroll
                    for (int bj = 0; bj < 2; ++bj)
#pragma unroll
                        for (int n = 0; n < 2; ++n) { const f32x4 x = PG8_AG(acc, ai, bj, m, n); q += (x[0] * x[0] + x[1] * x[1]) + (x[2] * x[2] + x[3] * x[3]); }
                    q = xor32_sum(xor16_sum(q));
                    sc = rs * __builtin_amdgcn_rsqf(rs * rs * q * (1.0f / 64.0f) + EPS) * post;
                }
                bf16_t* rowp = slotp + (size_t)row * 64;
#pragma unroll
                for (int bj = 0; bj < 2; ++bj) { const f32x4 v0 = PG8_AG(acc, ai, bj, m, 0) * sc * gv[bj][0], v1 = PG8_AG(acc, ai, bj, m, 1) * sc * gv[bj][1];
                    u32x4 w; w.x = cvt_pk_bf16(v0[0], v0[1]); w.y = cvt_pk_bf16(v0[2], v0[3]); w.z = cvt_pk_bf16(v1[0], v1[1]); w.w = cvt_pk_bf16(v1[2], v1[3]);
                    *(u32x4*)(rowp + 32 * bj) = w; }
            }
    }
};
template <bool F8>
struct EpiSwi {
    static constexpr int BMODE = 1, A_AUX = 0; static constexpr bool ALIGN = true, FP8 = F8; static constexpr int NST = 8;
    bf16_t* H; int ldh; const float* ss; const float* rowrs; const volatile LAS int* T;
    __device__ __forceinline__ float pre_load(const Unit& u, int tid) const {
        if (tid >= 256) return 0.f;
        if (rowrs) { const int idx = u.lt * BM + tid; return idx < T[u.e] ? rowrs[(size_t)u.e * CAP + idx] : 0.f; }
        return rstd_of(ss, u.pm * BM + tid); }
    __device__ __forceinline__ void pre_store(float v, int buf, LAS unsigned char* lds, int tid) const { if (tid < 256) ((LAS float*)(lds + RS_OFF))[buf * 256 + tid] = v; }
    __device__ __forceinline__ void operator()(const AccT& acc, const Unit& u, int wr, int wc, int fr, int fq, LAS unsigned char* lds, int, int buf) const {
        const int col0 = u.pn * HALF + 32 * wc + 8 * fq;
        const LAS float* RS = (const LAS float*)(lds + RS_OFF) + buf * 256;
        float rsv[2][4];
#pragma unroll
        for (int ai = 0; ai < 2; ++ai)
#pragma unroll
            for (int m = 0; m < 4; ++m) rsv[ai][m] = RS[ai * HALF + wr * 64 + m * 16 + fr];
#pragma unroll
        for (int ai = 0; ai < 2; ++ai)
#pragma unroll
            for (int m = 0; m < 4; ++m) {
                const int r = ai * HALF + wr * 64 + m * 16 + fr; const int row = u.pm * BM + r;
                const float rs = F8 ? rsv[ai][m] * (1.0f / (W8_SCALE * X8_SCALE)) : rsv[ai][m];
                const float tn = -rs * LOG2E, ic = __builtin_amdgcn_rcpf(rs * rs * (F8 ? H8_SCALE : 1.0f));
                const f32x2 tn2 = {tn, tn}, ic2 = {ic, ic};
                float h[8];
#pragma unroll
                for (int n = 0; n < 2; ++n) { const f32x4 g4 = PG8_AG(acc, ai, 0, m, n), u4 = PG8_AG(acc, ai, 1, m, n);
#pragma unroll
                    for (int p = 0; p < 2; ++p) { const f32x2 g2 = {g4[2 * p], g4[2 * p + 1]}, u2 = {u4[2 * p], u4[2 * p + 1]};
                        const f32x2 t2 = g2 * tn2; const f32x2 e2 = {__builtin_amdgcn_exp2f(t2.x), __builtin_amdgcn_exp2f(t2.y)};
                        const f32x2 d2 = __builtin_elementwise_fma(e2, ic2, ic2); const f32x2 r2 = {__builtin_amdgcn_rcpf(d2.x), __builtin_amdgcn_rcpf(d2.y)};
                        const f32x2 h2 = (g2 * u2) * r2; h[4 * n + 2 * p] = h2.x; h[4 * n + 2 * p + 1] = h2.y; } }
                if (F8) {
                    float c8[8];
#pragma unroll
                    for (int j = 0; j < 8; ++j) c8[j] = __builtin_amdgcn_fmed3f(h[j], -448.f, 448.f);
                    int w0 = 0, w1 = 0;
                    w0 = __builtin_amdgcn_cvt_pk_fp8_f32(c8[0], c8[1], w0, false); w0 = __builtin_amdgcn_cvt_pk_fp8_f32(c8[2], c8[3], w0, true);
                    w1 = __builtin_amdgcn_cvt_pk_fp8_f32(c8[4], c8[5], w1, false); w1 = __builtin_amdgcn_cvt_pk_fp8_f32(c8[6], c8[7], w1, true);
                    u32x2 w8; w8.x = (unsigned)w0; w8.y = (unsigned)w1; *(u32x2*)((unsigned char*)H + (size_t)row * ldh + col0) = w8;
                } else {
                    u32x4 w; w.x = cvt_pk_bf16(h[0], h[1]); w.y = cvt_pk_bf16(h[2], h[3]); w.z = cvt_pk_bf16(h[4], h[5]); w.w = cvt_pk_bf16(h[6], h[7]);
                    *(u32x4*)(H + (size_t)row * ldh + col0) = w; }
            }
    }
};
struct EpiRes {
    static constexpr int BMODE = 1, A_AUX = 0; static constexpr bool ALIGN = true, FP8 = false; static constexpr int NST = 0;
    bf16_t* xb; float* ssout; bf16_t* xout;
    __device__ __forceinline__ float pre_load(const Unit&, int) const { return 0.f; }
    __device__ __forceinline__ void pre_store(float, int, LAS unsigned char*, int) const {}
    __device__ __forceinline__ void operator()(const AccT& acc, const Unit& u, int wr, int wc, int fr, int fq, LAS unsigned char* lds, int tid, int) const {
        LAS float* P = (LAS float*)(lds + EPI_OFF);
        const int col0 = u.pn * BM + wc * 32 + 8 * fq;
#pragma unroll
        for (int ai = 0; ai < 2; ++ai) {
            u32x4 bb[4][2];
#pragma unroll
            for (int m = 0; m < 4; ++m)
#pragma unroll
                for (int bj = 0; bj < 2; ++bj) bb[m][bj] = *(const u32x4*)(xb + (size_t)(u.pm * BM + ai * HALF + wr * 64 + m * 16 + fr) * D + col0 + bj * HALF);
#pragma unroll
            for (int m = 0; m < 4; ++m) {
                const int r = ai * HALF + wr * 64 + m * 16 + fr; const size_t off = (size_t)(u.pm * BM + r) * D + col0;
                float q = 0.f;
#pragma unroll
                for (int bj = 0; bj < 2; ++bj) {
                    const u32x4 b = bb[m][bj];
                    const f32x4 v0 = PG8_AG(acc, ai, bj, m, 0) + (f32x4){bf_lo(b.x), bf_hi(b.x), bf_lo(b.y), bf_hi(b.y)}, v1 = PG8_AG(acc, ai, bj, m, 1) + (f32x4){bf_lo(b.z), bf_hi(b.z), bf_lo(b.w), bf_hi(b.w)};
                    u32x4 w; w.x = cvt_pk_bf16(v0[0], v0[1]); w.y = cvt_pk_bf16(v0[2], v0[3]); w.z = cvt_pk_bf16(v1[0], v1[1]); w.w = cvt_pk_bf16(v1[2], v1[3]);
                    *(u32x4*)(xout + off + bj * HALF) = w;
                    q += (v0[0] * v0[0] + v0[1] * v0[1]) + (v0[2] * v0[2] + v0[3] * v0[3]) + (v1[0] * v1[0] + v1[1] * v1[1]) + (v1[2] * v1[2] + v1[3] * v1[3]); }
                q = xor32_sum(xor16_sum(q));
                if (fq == 0) P[r * 4 + wc] = q;
            }
        }
        LDS_WAIT(); __builtin_amdgcn_s_barrier(); asm volatile("" ::: "memory");
        if (tid < 256) { const f32x4 p = *(const LAS f32x4*)(P + tid * 4); ssout[(size_t)(u.pm * BM + tid) * 4 + u.pn] = (p.x + p.y) + (p.z + p.w); }
        LDS_WAIT();
    }
};
struct EpiMoeDown {
    static constexpr int BMODE = 1, A_AUX = 0; static constexpr bool ALIGN = true, FP8 = true; static constexpr int NST = 0;
    bf16_t* y1; bf16_t* y2; bf16_t* yx; const unsigned* rowtok; const float* rowgate; const volatile LAS int* T;
    __device__ __forceinline__ float pre_load(const Unit&, int) const { return 0.f; }
    __device__ __forceinline__ void pre_store(float, int, LAS unsigned char*, int) const {}
    __device__ __forceinline__ void operator()(const AccT& acc, const Unit& u, int wr, int wc, int fr, int fq, LAS unsigned char*, int, int) const {
        const int col0 = u.pn * BM + wc * 32 + 8 * fq; const int cnt = T[u.e];
        unsigned tkv[2][4]; float gtv[2][4];
#pragma unroll
        for (int ai = 0; ai < 2; ++ai)
#pragma unroll
            for (int m = 0; m < 4; ++m) { const int idx = u.lt * BM + ai * HALF + wr * 64 + m * 16 + fr; const bool ok = idx < cnt;
                tkv[ai][m] = ok ? rowtok[(size_t)u.e * CAP + idx] : 0u; gtv[ai][m] = ok ? rowgate[(size_t)u.e * CAP + idx] * (Y8_SCALE / (H8_SCALE * W8_SCALE)) : 0.f; }
#pragma unroll
        for (int ai = 0; ai < 2; ++ai)
#pragma unroll
            for (int m = 0; m < 4; ++m) {
                const int r = ai * HALF + wr * 64 + m * 16 + fr; const int idx = u.lt * BM + r;
                if (idx < cnt) {
                    const unsigned tk = tkv[ai][m]; const float gt = gtv[ai][m];
                    unsigned char* dst = (u.aux >= 0 ? (unsigned char*)yx + (size_t)(u.aux * BM + r) * D : (unsigned char*)((tk >> 31) ? y2 : y1) + (size_t)(tk & 0x7fffffffu) * D) + col0;
#pragma unroll
                    for (int bj = 0; bj < 2; ++bj) { const f32x4 v0 = PG8_AG(acc, ai, bj, m, 0) * gt, v1 = PG8_AG(acc, ai, bj, m, 1) * gt;
                        u32x2 w; w.x = cvt_pk4_fp8(v0[0], v0[1], v0[2], v0[3]); w.y = cvt_pk4_fp8(v1[0], v1[1], v1[2], v1[3]);
                        *(u32x2*)(dst + bj * HALF) = w; }
                }
            }
    }
};
}
#define XB_TMO      128
#define XB_XCNT(j)  (256  + 64 * (j))
#define XB_XSUB(j)  (1280 + 64 * (j))
#define XB_XGEN(j)  (2304 + 64 * (j))
#define XB_TOP      3328
#define XB_TOPGEN   3392
#define XCD_BAR_WORDS 3456
#define XB_SPIN_CAP (1u << 18)

__device__ __forceinline__ unsigned xb_ld(unsigned* p)              { return __hip_atomic_load(p, __ATOMIC_RELAXED, __HIP_MEMORY_SCOPE_AGENT); }
__device__ __forceinline__ unsigned xb_add(unsigned* p, unsigned v) { return __hip_atomic_fetch_add(p, v, __ATOMIC_RELAXED, __HIP_MEMORY_SCOPE_AGENT); }
__device__ __forceinline__ unsigned xb_xcc_id() { return (unsigned)__builtin_amdgcn_s_getreg((3 << 11) | 20) & 0xFu; }
#define XB_SPIN(cond, bar) do { unsigned _sp = 0; while (cond) { __builtin_amdgcn_s_sleep(1); \
    if ((++_sp & 255u) == 0u) { if (xb_ld(&(bar)[XB_TMO])) break; if (_sp > XB_SPIN_CAP) { atomicAdd(&(bar)[XB_TMO], 1u); break; } } } } while (0)

struct XcdBarrier {
    unsigned* bar; unsigned x;
    volatile LAS unsigned* st;
};

__device__ __forceinline__ XcdBarrier xcd_barrier_post(unsigned* bar, volatile LAS unsigned* st) {
    XcdBarrier b; b.bar = bar; b.x = xb_xcc_id(); b.st = st;
    if (threadIdx.x == 0) (void)xb_add(&bar[XB_XCNT(b.x)], 1u);
    return b;
}
__device__ __forceinline__ void xcd_barrier_complete(unsigned* bar, unsigned x, unsigned& nloc, unsigned& nx) {
    const unsigned G = gridDim.x * gridDim.y * gridDim.z;
    unsigned sum, cnt, mine, sp = 0u;
    for (;;) {
        sum = 0u; cnt = 0u; mine = 0u;
#pragma unroll
        for (unsigned j = 0; j < 16; ++j) { const unsigned c = xb_ld(&bar[XB_XCNT(j)]); sum += c; cnt += (c > 0u) ? 1u : 0u; mine = (j == x) ? c : mine; }
        if (sum == G) break;
        __builtin_amdgcn_s_sleep(1);
        if ((++sp & 255u) == 0u) { if (xb_ld(&bar[XB_TMO])) break; if (sp > XB_SPIN_CAP) { atomicAdd(&bar[XB_TMO], 1u); break; } }
    }
    nloc = mine > 0u ? mine : 1u; nx = cnt > 0u ? cnt : 1u;
}

__device__ __forceinline__ void xcd_barrier(const XcdBarrier& b) {
    asm volatile("s_waitcnt vmcnt(0)" ::: "memory");
    __syncthreads();
    if (threadIdx.x == 0) {
        unsigned* bar = b.bar;
        __builtin_amdgcn_s_waitcnt(0);
        unsigned nloc = b.st[0], nx = b.st[1];
        if (nloc == 0u) { xcd_barrier_complete(bar, b.x, nloc, nx); b.st[0] = nloc; b.st[1] = nx; }
        const unsigned old = xb_add(&bar[XB_XSUB(b.x)], 1u);
        const unsigned gen = old / nloc;
        if (old + 1u == (gen + 1u) * nloc) {
            __builtin_amdgcn_fence(__ATOMIC_RELEASE, "agent");
            asm volatile("s_waitcnt vmcnt(0)" ::: "memory");
            const unsigned og = xb_add(&bar[XB_TOP], 1u);
            const unsigned tg = og / nx;
            if (og + 1u == (tg + 1u) * nx) xb_add(&bar[XB_TOPGEN], 1u);
            else XB_SPIN(xb_ld(&bar[XB_TOPGEN]) == tg, bar);
            __builtin_amdgcn_fence(__ATOMIC_ACQUIRE, "agent");
            xb_add(&bar[XB_XGEN(b.x)], 1u);
            asm volatile("s_waitcnt vmcnt(0)" ::: "memory");
        } else {
            XB_SPIN(xb_ld(&bar[XB_XGEN(b.x)]) == gen, bar);
            __builtin_amdgcn_fence(__ATOMIC_ACQUIRE, "agent");
            asm volatile("s_waitcnt vmcnt(0)" ::: "memory");
        }
    }
    __syncthreads();
}
namespace att {
constexpr int TILE_B = 8192, OROW = 144, OSTG = 32 * OROW;
__device__ __forceinline__ void glds16(const void* g, LAS unsigned char* l) { __builtin_amdgcn_global_load_lds((const unsigned*)g, (LAS unsigned*)l, 16, 0, 0); }
__device__ __forceinline__ s16x4 vtr(const LAS unsigned char* p) { typedef short v4i16_t __attribute__((ext_vector_type(4))); return __builtin_bit_cast(s16x4, __builtin_amdgcn_ds_read_tr16_b64_v4i16((LAS v4i16_t*)p)); }

__device__ __forceinline__ void stage_tile(LAS unsigned char* kt, LAS unsigned char* vt, const bf16_t* Kg, const bf16_t* Vg, int pitch, int ktok, int vtok, int wid, int lane) {
    const int c = (lane & 7) ^ ((4 * wid + (lane >> 4)) & 7);
    glds16(Kg + (size_t)ktok * pitch + c * 8, kt + wid * 1024);
    glds16(Vg + (size_t)vtok * pitch + (wid >> 2) * 32 + (lane & 3) * 8, vt + wid * 1024);
}
__device__ __forceinline__ void fetch_tile(u32x4& kreg, u32x4& vreg, const bf16_t* Kg, const bf16_t* Vg, int pitch, int ktok, int vtok, int wid, int lane) {
    const int c = (lane & 7) ^ ((4 * wid + (lane >> 4)) & 7);
    kreg = *(const u32x4*)(Kg + (size_t)ktok * pitch + c * 8);
    vreg = *(const u32x4*)(Vg + (size_t)vtok * pitch + (wid >> 2) * 32 + (lane & 3) * 8);
}
__device__ __forceinline__ void commit_tile(LAS unsigned char* kt, LAS unsigned char* vt, const u32x4& kreg, const u32x4& vreg, int wid, int lane) {
    *(LAS u32x4*)(kt + wid * 1024 + lane * 16) = kreg; *(LAS u32x4*)(vt + wid * 1024 + lane * 16) = vreg;
}
__device__ __forceinline__ int crow(int r) { return (r & 3) + 8 * (r >> 2); }

template <class CI, class PM>
__device__ __forceinline__ void half_step(const LAS unsigned char* kaddr, const unsigned (&so)[4], const LAS unsigned char* vb, const unsigned (&vo)[4], const bf16x8 (&qr)[4], f32x16 (&o)[2], float& lrun, const CI& ci, const PM& pm) {
    f32x16 p;
#pragma unroll
    for (int r = 0; r < 16; ++r) p[r] = ci(crow(r));
#pragma unroll
    for (int d0 = 0; d0 < 4; ++d0) p = __builtin_amdgcn_mfma_f32_32x32x16_bf16(*(const LAS bf16x8*)(kaddr + so[d0]), qr[d0], p, 0, 0, 0);
    float rs = 0.f;
#pragma unroll
    for (int r = 0; r < 16; ++r) { p[r] = __builtin_amdgcn_exp2f(pm(p[r], crow(r))); rs += p[r]; }
    lrun += rs;
    u32x4 pw0, pw1;
#pragma unroll
    for (int j = 0; j < 4; ++j) { pw0[j] = cvt_pk_bf16(p[2 * j], p[2 * j + 1]); pw1[j] = cvt_pk_bf16(p[8 + 2 * j], p[9 + 2 * j]); }
#pragma unroll
    for (int d0 = 0; d0 < 2; ++d0) {
        const s16x4 a0 = vtr(vb + vo[0] + d0 * 4096), a1 = vtr(vb + vo[1] + d0 * 4096), b0 = vtr(vb + vo[2] + d0 * 4096), b1 = vtr(vb + vo[3] + d0 * 4096);
        o[d0] = __builtin_amdgcn_mfma_f32_32x32x16_bf16((bf16x8){a0[0], a0[1], a0[2], a0[3], a1[0], a1[1], a1[2], a1[3]}, __builtin_bit_cast(bf16x8, pw0), o[d0], 0, 0, 0);
        o[d0] = __builtin_amdgcn_mfma_f32_32x32x16_bf16((bf16x8){b0[0], b0[1], b0[2], b0[3], b1[0], b1[1], b1[2], b1[3]}, __builtin_bit_cast(bf16x8, pw1), o[d0], 0, 0, 0);
    }
}
__device__ __forceinline__ void store_o(bf16_t* orow, const f32x16 (&o)[2], float inv, int hi) {
#pragma unroll
    for (int d0 = 0; d0 < 2; ++d0)
#pragma unroll
        for (int gq = 0; gq < 4; ++gq) { u32x2 w; w.x = cvt_pk_bf16(o[d0][4 * gq] * inv, o[d0][4 * gq + 1] * inv); w.y = cvt_pk_bf16(o[d0][4 * gq + 2] * inv, o[d0][4 * gq + 3] * inv);
            *(u32x2*)(orow + 32 * d0 + 8 * gq + 4 * hi) = w; }
}
template <bool FULL>
__device__ __forceinline__ void stage_o(LAS unsigned char* stg, const f32x16 (&o)[2], float inv, int r32, int hi) {
#pragma unroll
    for (int d0 = 0; d0 < 2; ++d0)
#pragma unroll
        for (int gq = 0; gq < 4; ++gq) { u32x2 w; w.x = cvt_pk_bf16(o[d0][4 * gq] * inv, o[d0][4 * gq + 1] * inv); w.y = cvt_pk_bf16(o[d0][4 * gq + 2] * inv, o[d0][4 * gq + 3] * inv);
            if (FULL) *(LAS u32x2*)(stg + r32 * OROW + (32 * d0 + 8 * gq + 4 * hi) * 2) = w; else *(LAS u32x2*)(stg + d0 * 2048 + r32 * 64 + (8 * gq + 4 * hi) * 2) = w; }
}
template <bool FULL, class RP>
__device__ __forceinline__ void flush_o(const LAS unsigned char* stg, int lane, const RP& rowptr) {
    if (FULL) {
#pragma unroll
        for (int i = 0; i < 4; ++i) { const int row = i * 8 + (lane >> 3), ch = lane & 7; const u32x4 v = *(const LAS u32x4*)(stg + row * OROW + ch * 16); *(u32x4*)(rowptr(row) + ch * 8) = v; }
    } else {
#pragma unroll
        for (int d0 = 0; d0 < 2; ++d0)
#pragma unroll
            for (int i = 0; i < 2; ++i) { const int row = i * 16 + (lane >> 2), ch = lane & 3; const u32x4 v = *(const LAS u32x4*)(stg + d0 * 2048 + row * 64 + ch * 16); *(u32x4*)(rowptr(row) + 32 * d0 + ch * 8) = v; }
    }
}
struct HS { const LAS unsigned char* ka; const LAS unsigned char* vb; const LAS float* tb; };
template <int NT, bool MASK, class HSF>
__device__ __forceinline__ void pipe_rows(const HSF& hsf, const unsigned (&so)[4], const unsigned (&vo)[4], const bf16x8 (&qr)[4], f32x16 (&o)[2], float& lrun, const int wm) {
#define ATT_SB() __builtin_amdgcn_sched_barrier(0)
#define ATT_E(r) do { const float x_ = __builtin_amdgcn_exp2f(pc[r]); pc[r] = MASK ? __builtin_bit_cast(float, __builtin_bit_cast(unsigned, x_) & (unsigned)__builtin_amdgcn_sbfe(wm, crow(r), 1)) : x_; rs += pc[r]; } while (0)
#define ATT_KF(d0) (*(const LAS bf16x8*)(hn.ka + so[d0]))
#define ATT_V8(a_, b_) ((bf16x8){a_[0], a_[1], a_[2], a_[3], b_[0], b_[1], b_[2], b_[3]})
    f32x16 pc;
    { const HS h = hsf(0);
#pragma unroll
      for (int r = 0; r < 16; ++r) pc[r] = h.tb[crow(r)];
#pragma unroll
      for (int d0 = 0; d0 < 4; ++d0) pc = __builtin_amdgcn_mfma_f32_32x32x16_bf16(*(const LAS bf16x8*)(h.ka + so[d0]), qr[d0], pc, 0, 0, 0); }
#pragma unroll
    for (int t = 0; t < NT; ++t) {
        const bool more = t + 1 < NT;
        const HS h = hsf(t); const HS hn = hsf(more ? t + 1 : t);
        f32x16 pn; bf16x8 k0, k1; float rs = 0.f;
        if (more) {
#pragma unroll
            for (int r = 0; r < 16; ++r) pn[r] = hn.tb[crow(r)];
            k0 = ATT_KF(0); k1 = ATT_KF(1);
        }
        const s16x4 a00 = vtr(h.vb + vo[0]), a01 = vtr(h.vb + vo[1]), a10 = vtr(h.vb + vo[0] + 4096), a11 = vtr(h.vb + vo[1] + 4096);
        ATT_SB();
        if (more) pn = __builtin_amdgcn_mfma_f32_32x32x16_bf16(k0, qr[0], pn, 0, 0, 0);
        if (more) k0 = ATT_KF(2);
        ATT_E(0); ATT_E(1); ATT_E(2); ATT_E(3);
        ATT_SB();
        if (more) pn = __builtin_amdgcn_mfma_f32_32x32x16_bf16(k1, qr[1], pn, 0, 0, 0);
        if (more) k1 = ATT_KF(3);
        const s16x4 b00 = vtr(h.vb + vo[2]), b01 = vtr(h.vb + vo[3]), b10 = vtr(h.vb + vo[2] + 4096), b11 = vtr(h.vb + vo[3] + 4096);
        ATT_E(4); ATT_E(5); ATT_E(6); ATT_E(7);
        u32x4 pw0, pw1;
#pragma unroll
        for (int j = 0; j < 4; ++j) pw0[j] = cvt_pk_bf16(pc[2 * j], pc[2 * j + 1]);
        ATT_SB();
        if (more) pn = __builtin_amdgcn_mfma_f32_32x32x16_bf16(k0, qr[2], pn, 0, 0, 0);
        o[0] = __builtin_amdgcn_mfma_f32_32x32x16_bf16(ATT_V8(a00, a01), __builtin_bit_cast(bf16x8, pw0), o[0], 0, 0, 0);
        ATT_E(8); ATT_E(9); ATT_E(10); ATT_E(11);
        ATT_SB();
        if (more) pn = __builtin_amdgcn_mfma_f32_32x32x16_bf16(k1, qr[3], pn, 0, 0, 0);
        o[1] = __builtin_amdgcn_mfma_f32_32x32x16_bf16(ATT_V8(a10, a11), __builtin_bit_cast(bf16x8, pw0), o[1], 0, 0, 0);
        ATT_E(12); ATT_E(13); ATT_E(14); ATT_E(15);
#pragma unroll
        for (int j = 0; j < 4; ++j) pw1[j] = cvt_pk_bf16(pc[8 + 2 * j], pc[9 + 2 * j]);
        lrun += rs;
        ATT_SB();
        o[0] = __builtin_amdgcn_mfma_f32_32x32x16_bf16(ATT_V8(b00, b01), __builtin_bit_cast(bf16x8, pw1), o[0], 0, 0, 0);
        o[1] = __builtin_amdgcn_mfma_f32_32x32x16_bf16(ATT_V8(b10, b11), __builtin_bit_cast(bf16x8, pw1), o[1], 0, 0, 0);
        if (more) pc = pn;
    }
#undef ATT_SB
#undef ATT_E
#undef ATT_KF
#undef ATT_V8
}
struct TabCI { const LAS float* tb; __device__ __forceinline__ float operator()(int kc) const { return tb[kc]; } };
struct NoPM { __device__ __forceinline__ float operator()(float t, int) const { return t; } };
struct WinPM {
    int wm;
    __device__ __forceinline__ float operator()(float t, int kc) const {
        const int m = __builtin_amdgcn_sbfe(wm, kc, 1);
        return __builtin_bit_cast(float, (__builtin_bit_cast(unsigned, t) & (unsigned)m) | (~(unsigned)m & 0xff800000u)); }
};
__device__ __forceinline__ float wave_max(float v) {
#pragma unroll
    for (int o = 1; o < 64; o <<= 1) v = fmaxf(v, __shfl_xor(v, o));
    return v;
}
__device__ __forceinline__ float qk_bound(const float* gq, const float* gk, int lane) { return 64.f * C2 * wave_max(fabsf(gq[lane])) * wave_max(fabsf(gk[lane])); }
}
struct Args { const float* in[24]; float* out; unsigned char* ws; int ph_lo, ph_hi, li, pad; };
typedef Args Ptrs;
constexpr int NWAVES = 8;

struct ConvItem { const float* W; const float* gain; bf16_t* WT; int N, Kd, k0, n0, drow0, f8; };
__device__ __forceinline__ void conv_load(f32x4 (&v)[16], const ConvItem& it, int lane) {
    const float* src = it.W + (size_t)(it.k0 + (lane >> 4)) * it.N + it.n0 + 4 * (lane & 15);
#pragma unroll
    for (int i = 0; i < 16; ++i) v[i] = __builtin_nontemporal_load((const f32x4*)(src + (size_t)(4 * i) * it.N));
}
__device__ __forceinline__ void conv_to_lds(const f32x4 (&v)[16], const ConvItem& it, LAS float* scr, int lane) {
#pragma unroll
    for (int i = 0; i < 16; ++i) { const int kk = 4 * i + (lane >> 4); const float gk = it.gain ? it.gain[it.k0 + kk] : 1.f; LAS float* d = scr + kk * 65 + 4 * (lane & 15);
        d[0] = v[i].x * gk; d[1] = v[i].y * gk; d[2] = v[i].z * gk; d[3] = v[i].w * gk; }
    LDS_WAIT(); asm volatile("" ::: "memory");
}
__device__ __forceinline__ void conv_from_lds(const ConvItem& it, LAS float* scr, int lane) {
    const int c = lane & 7;
#pragma unroll
    for (int j = 0; j < 8; ++j) { const int n = (lane >> 3) + 8 * j; const LAS float* s = scr + (8 * c) * 65 + n;
        u32x4 o; o.x = pk2(s[0 * 65], s[1 * 65]); o.y = pk2(s[2 * 65], s[3 * 65]); o.z = pk2(s[4 * 65], s[5 * 65]); o.w = pk2(s[6 * 65], s[7 * 65]);
        *(u32x4*)(it.WT + (size_t)(it.drow0 + n) * it.Kd + it.k0 + 8 * c) = o; }
    LDS_WAIT(); asm volatile("" ::: "memory");
}
__device__ __forceinline__ void conv_from_lds8(const ConvItem& it, LAS float* scr, int lane) {
    const int c = lane & 3; unsigned char* WT8 = (unsigned char*)it.WT;
#pragma unroll
    for (int j = 0; j < 4; ++j) { const int n = (lane >> 2) + 16 * j; const LAS float* s = scr + (16 * c) * 65 + n;
        u32x4 o;
#pragma unroll
        for (int q = 0; q < 4; ++q) { int w = 0;
            w = __builtin_amdgcn_cvt_pk_fp8_f32(s[(4 * q + 0) * 65] * W8_SCALE, s[(4 * q + 1) * 65] * W8_SCALE, w, false);
            w = __builtin_amdgcn_cvt_pk_fp8_f32(s[(4 * q + 2) * 65] * W8_SCALE, s[(4 * q + 3) * 65] * W8_SCALE, w, true); o[q] = (unsigned)w; }
        *(u32x4*)(WT8 + (size_t)(it.drow0 + n) * it.Kd + it.k0 + 16 * c) = o; }
    LDS_WAIT(); asm volatile("" ::: "memory");
}
__device__ __forceinline__ void conv_out(const ConvItem& it, LAS float* scr, int lane) { if (it.f8) conv_from_lds8(it, scr, lane); else conv_from_lds(it, scr, lane); }
__device__ __forceinline__ ConvItem conv_matrix_item(const float* W, int K, int N, const float* gain, bf16_t* WT, int ileave, int item) {
    const int nnb = N / 64, kb = item / nnb, nb = item % nnb, n0 = 64 * nb;
    ConvItem it; it.W = W; it.gain = gain; it.WT = WT; it.N = N; it.Kd = K; it.k0 = 64 * kb; it.n0 = n0; it.f8 = 0;
    it.drow0 = ileave == 0 ? n0 : ((n0 >> 7) * 256 + (n0 & 127) + (ileave == 2 ? 128 : 0));
    return it;
}
__device__ __forceinline__ ConvItem p0_expert_item(const Ptrs& P, int r) {
    unsigned char* ws = P.ws;
    constexpr int I_GE = (D / 64) * (FFE / 64), I_DE = (FFE / 64) * (D / 64);
    const int per_e = 2 * I_GE + I_DE; const int e = r / per_e; r -= e * per_e;
    if (r < I_GE) { ConvItem c = conv_matrix_item(P.in[21] + (size_t)e * D * FFE, D, FFE, P.in[19], (bf16_t*)(ws + WS_WGUE + (size_t)e * 2 * FFE * D), 1, r); c.f8 = 1; return c; } r -= I_GE;
    if (r < I_GE) { ConvItem c = conv_matrix_item(P.in[22] + (size_t)e * D * FFE, D, FFE, P.in[19], (bf16_t*)(ws + WS_WGUE + (size_t)e * 2 * FFE * D), 2, r); c.f8 = 1; return c; } r -= I_GE;
    { ConvItem c = conv_matrix_item(P.in[23] + (size_t)e * FFE * D, FFE, D, nullptr, (bf16_t*)(ws + WS_WDE + (size_t)e * D * FFE), 0, r); c.f8 = 1; return c; }
}
constexpr int P0_DEFER_A = 192 * 8 * 3, P0_DEFER_B = 128 * 8 * 3, P0_C_PER_WAVE = 8, P0_DEFER_C = 256 * 4 * P0_C_PER_WAVE, P0_DEFER_F = 256 * 4 * 4, P0_DEFER_H = 256 * 4 * 4, P0_DEFER = P0_DEFER_A + P0_DEFER_B;
__device__ __forceinline__ ConvItem p0_item(const Ptrs& P, int r) {
    unsigned char* ws = P.ws;
    constexpr int I_IN = (D / 64) * (N_IN0 / 64), I_O = (D / 64) * (D / 64), I_G0 = (D / 64) * (FF0 / 64), I_D0 = (FF0 / 64) * (D / 64), I_Q1 = (D / 64) * (N_QKV1 / 64);
    constexpr int I_E = NE * 3 * (D / 64) * (FFE / 64), I_E1 = I_E - P0_DEFER_B, I_DENSE = 2 * I_O + 2 * I_G0 + I_D0 + I_Q1;
    if (r < I_IN) return conv_matrix_item(P.in[2], D, N_IN0, P.in[1], (bf16_t*)(ws + WS_WIN), 0, r); r -= I_IN;
    if (r < I_E1) return p0_expert_item(P, r); r -= I_E1;
    if (r >= I_DENSE) return p0_expert_item(P, I_E1 + r - I_DENSE);
    if (r < I_O) return conv_matrix_item(P.in[8], D, D, nullptr, (bf16_t*)(ws + WS_WOUT0), 0, r); r -= I_O;
    if (r < I_G0) return conv_matrix_item(P.in[10], D, FF0, P.in[9], (bf16_t*)(ws + WS_WGU0), 1, r); r -= I_G0;
    if (r < I_G0) return conv_matrix_item(P.in[11], D, FF0, P.in[9], (bf16_t*)(ws + WS_WGU0), 2, r); r -= I_G0;
    if (r < I_D0) return conv_matrix_item(P.in[12], FF0, D, nullptr, (bf16_t*)(ws + WS_WD0), 0, r); r -= I_D0;
    if (r < I_Q1) return conv_matrix_item(P.in[14], D, N_QKV1, P.in[13], (bf16_t*)(ws + WS_WQKV1), 0, r); r -= I_Q1;
    return conv_matrix_item(P.in[18], D, D, nullptr, (bf16_t*)(ws + WS_WOUT1), 0, r);
}
constexpr int P0_ITEMS = (D / 64) * (N_IN0 / 64) + 2 * (D / 64) * (D / 64) + 3 * (D / 64) * (FF0 / 64) + (D / 64) * (N_QKV1 / 64) + NE * 3 * (D / 64) * (FFE / 64);
static_assert(P0_DEFER_A >= 2 * (D / 64) * (D / 64) + 3 * (D / 64) * (FF0 / 64) + (D / 64) * (N_QKV1 / 64), "block A holds every dense matrix but w_in");
static_assert(P0_ITEMS - P0_DEFER - P0_DEFER_C - P0_DEFER_F - P0_DEFER_H >= (D / 64) * (N_IN0 / 64), "blocks C, F, H hold expert (e4m3) items only; w_in stays in the prologue");
__device__ __forceinline__ void p0_tail_items(const Ptrs& P, LAS unsigned char* lds, int first, int n, int wave, int lane) {
    LAS float* scr = (LAS float*)(lds + wave * 16640); f32x4 v[16];
    for (int j = 0; j < n; ++j) { const ConvItem c = p0_item(P, first + j); conv_load(v, c, lane); conv_to_lds(v, c, scr, lane); conv_out(c, scr, lane); }
}
__device__ __forceinline__ void convr_load(f32x4 (&v)[16], float (&g)[16], const ConvItem& it, int lane) {
    const float* src = it.W + (size_t)(it.k0 + 16 * (lane >> 4)) * it.N + it.n0 + 4 * (lane & 15);
#pragma unroll
    for (int i = 0; i < 16; ++i) v[i] = __builtin_nontemporal_load((const f32x4*)(src + (size_t)i * it.N));
#pragma unroll
    for (int i = 0; i < 16; ++i) g[i] = it.gain ? it.gain[it.k0 + 16 * (lane >> 4) + i] : 1.f;
}
__device__ __forceinline__ void convr_out8(const f32x4 (&v)[16], const float (&g)[16], const ConvItem& it, int lane) {
    unsigned char* dst = (unsigned char*)it.WT + (size_t)(it.drow0 + 4 * (lane & 15)) * it.Kd + it.k0 + 16 * (lane >> 4);
#pragma unroll
    for (int j = 0; j < 4; ++j) { u32x4 o;
#pragma unroll
        for (int q = 0; q < 4; ++q) { int w = 0;
            w = __builtin_amdgcn_cvt_pk_fp8_f32(v[4 * q][j] * (g[4 * q] * W8_SCALE), v[4 * q + 1][j] * (g[4 * q + 1] * W8_SCALE), w, false);
            w = __builtin_amdgcn_cvt_pk_fp8_f32(v[4 * q + 2][j] * (g[4 * q + 2] * W8_SCALE), v[4 * q + 3][j] * (g[4 * q + 3] * W8_SCALE), w, true); o[q] = (unsigned)w; }
        *(u32x4*)(dst + (size_t)j * it.Kd) = o; }
}
__device__ __forceinline__ void p0_prologue(const Ptrs& P, LAS unsigned char* lds, int gw, int NGW, int wave, int lane, int G) {
    LAS float* scr = (LAS float*)(lds + wave * 16640);
    unsigned char* ws = P.ws;
    const int NITEMS = (G == 256) ? P0_ITEMS - P0_DEFER - P0_DEFER_C - P0_DEFER_F - P0_DEFER_H : P0_ITEMS;
    f32x4 va[16], vb[16];
    int it = gw;
    if (it < NITEMS) { const ConvItem c0 = p0_item(P, it); conv_load(va, c0, lane); }
#pragma unroll 1
    for (; it < NITEMS; it += 2 * NGW) {
        { const ConvItem c0 = p0_item(P, it); conv_to_lds(va, c0, scr, lane);
          if (it + NGW < NITEMS) { const ConvItem c1 = p0_item(P, it + NGW); conv_load(vb, c1, lane); }
          conv_out(c0, scr, lane); }
        if (it + NGW < NITEMS) { const ConvItem c1 = p0_item(P, it + NGW); conv_to_lds(vb, c1, scr, lane);
          if (it + 2 * NGW < NITEMS) { const ConvItem c2 = p0_item(P, it + 2 * NGW); conv_load(va, c2, lane); }
          conv_out(c1, scr, lane); }
    }
    const float* x = P.in[0]; bf16_t* xb = (bf16_t*)(ws + WS_XB); float* ss0 = (float*)(ws + WS_SS);
    for (int m = gw; m < M; m += NGW) {
        const f32x4* xr = (const f32x4*)(x + (size_t)m * D) + lane; f32x4 v[4]; float s = 0.f;
#pragma unroll
        for (int j = 0; j < 4; ++j) { v[j] = __builtin_nontemporal_load(xr + 64 * j); s += (v[j].x * v[j].x + v[j].y * v[j].y) + (v[j].z * v[j].z + v[j].w * v[j].w); }
        s = wave_sum(s);
        u32x2* o8 = (u32x2*)(xb + (size_t)m * D) + lane;
#pragma unroll
        for (int j = 0; j < 4; ++j) { u32x2 w; w.x = pk2(v[j].x, v[j].y); w.y = pk2(v[j].z, v[j].w); o8[64 * j] = w; }
        if (lane == 0) *(f32x4*)(ss0 + (size_t)m * 4) = (f32x4){s, 0.f, 0.f, 0.f};
    }
}

struct ADesc { int b, h, r, cfg, p, l0, seg, tokb; };
template <bool FINAL>
__device__ __forceinline__ ADesc decodeA(int a) {
    ADesc d; const int cfg = FINAL ? 2 : (a >> 9), rem = a & 511; d.cfg = cfg; d.b = rem >> 7; d.h = (rem >> 4) & 7; d.r = cfg == 0 ? 1 : (cfg == 1 ? 4 : 16);
    const int idx16 = rem & 15, nblk = 16 / d.r; d.p = idx16 / nblk; d.l0 = 256 * (idx16 % nblk); d.seg = SEQ / d.r; d.tokb = d.b * SEQ + d.p; return d; }
__device__ __forceinline__ void fetchA(const Ptrs& P, const ADesc& d, u32x4 (&kq)[6], u32x4 (&vq)[6], bf16x8 (&qn)[4], int wid, int lane) {
    const bf16_t* QKV = (const bf16_t*)(P.ws + WS_QKV); const bf16_t* Kg = QKV + (size_t)(8 + d.h) * M * 64; const bf16_t* Vg = QKV + (size_t)(16 + d.h) * M * 64;
#pragma unroll
    for (int t = 0; t < 6; ++t) {
        int kd = d.l0 - 64 + 64 * t + 8 * wid + (lane >> 3); kd = kd < 0 ? 0 : (kd > d.seg - 1 ? d.seg - 1 : kd);
        int vd = d.l0 - 64 + 64 * t + 16 * (wid & 3) + (lane >> 2); vd = vd < 0 ? 0 : (vd > d.seg - 1 ? d.seg - 1 : vd);
        att::fetch_tile(kq[t], vq[t], Kg, Vg, 64, d.tokb + kd * d.r, d.tokb + vd * d.r, wid, lane); }
    const int tok = d.tokb + (d.l0 + 32 * wid + (lane & 31)) * d.r;
#pragma unroll
    for (int d0 = 0; d0 < 4; ++d0) qn[d0] = *(const bf16x8*)(QKV + ((size_t)d.h * M + tok) * 64 + 16 * d0 + 8 * (lane >> 5));
}
__device__ __forceinline__ void fetchPart(const Ptrs& P, const ADesc& d, u32x2 (&pp)[16], float (&pl)[2], int wid, int lane) {
    const int hi = lane >> 5; const int tok = d.tokb + (d.l0 + 32 * wid + (lane & 31)) * d.r;
    const bf16_t* p1 = (const bf16_t*)(P.ws + WS_PA1) + (size_t)tok * 512 + d.h * 64; const bf16_t* p4 = (const bf16_t*)(P.ws + WS_PA4) + (size_t)tok * 512 + d.h * 64;
#pragma unroll
    for (int i = 0; i < 8; ++i) { const int c = 32 * (i >> 2) + 8 * (i & 3) + 4 * hi; pp[i] = *(const u32x2*)(p1 + c); pp[8 + i] = *(const u32x2*)(p4 + c); }
    const float* LS = (const float*)(P.ws + WS_LSE); pl[0] = LS[(size_t)tok * 8 + d.h]; pl[1] = LS[(size_t)M * 8 + (size_t)tok * 8 + d.h];
}
template <bool FINAL>
__device__ __forceinline__ void attnA_run(const Ptrs& P, LAS unsigned char* lds, int afirst, int astep, int aend, int wid, int lane, int tid) {
    const int r32 = lane & 31, hi = lane >> 5;
    LAS unsigned char* Kb = lds; LAS unsigned char* Vb = lds + 6 * att::TILE_B; LAS float* tab = (LAS float*)(lds + 12 * att::TILE_B);
    LAS unsigned char* stg = lds + 12 * att::TILE_B + 1024 + wid * att::OSTG;
    if (afirst >= aend) return;
    const float shift = __builtin_bit_cast(float, ((const volatile LAS unsigned*)(lds + MISC_OFF))[56]);
    unsigned so[4], vo[4];
    { const unsigned x = (unsigned)(r32 >> 1) & 7u;
#pragma unroll
      for (int d0 = 0; d0 < 4; ++d0) so[d0] = (((unsigned)(2 * d0 + hi)) ^ x) << 4;
      const unsigned vl = (unsigned)(((lane >> 4) & 1) * 32 + (lane & 3) * 8 + (4 * hi + ((lane & 15) >> 2)) * 64);
      vo[0] = vl; vo[1] = vl + 512u; vo[2] = vl + 1024u; vo[3] = vl + 1536u; }
    u32x4 kq[6], vq[6]; bf16x8 qn[4]; u32x2 pp[16]; float pl[2] = {0.f, 0.f};
    { const ADesc d0_ = decodeA<FINAL>(afirst); fetchA(P, d0_, kq, vq, qn, wid, lane); if (FINAL) fetchPart(P, d0_, pp, pl, wid, lane); }
    bf16_t* prow = nullptr; int prstep = 0; float* pls = nullptr; float plv = 0.f;
#pragma unroll 1
    for (int a = afirst; a < aend; a += astep) {
        const ADesc d = decodeA<FINAL>(a);
#pragma unroll
        for (int t = 0; t < 6; ++t) att::commit_tile(Kb + t * att::TILE_B, Vb + t * att::TILE_B, kq[t], vq[t], wid, lane);
        bf16x8 qr[4];
#pragma unroll
        for (int d0 = 0; d0 < 4; ++d0) qr[d0] = qn[d0];
        u32x2 pc[16]; float plc[2];
        if (FINAL) {
#pragma unroll
            for (int i = 0; i < 16; ++i) pc[i] = pp[i];
            plc[0] = pl[0]; plc[1] = pl[1]; }
        const float cs = __builtin_amdgcn_exp2f(-(float)(2 * d.h + 1) * 0.5f) * (float)d.r * LOG2E;
        if (tid < 256) { const float ad = fabsf((float)(128 - tid)); tab[tid] = ad <= 64.f ? -cs * ad - shift : -INFINITY; }
        LDS_WAIT(); __syncthreads();
        if (prow) { att::flush_o<true>(stg, lane, [&](int row) { return prow + (size_t)row * prstep; }); if (!FINAL && hi == 0) *pls = plv; }
        { ADesc dn = decodeA<FINAL>(a + astep < aend ? a + astep : a); if (!(a + astep < aend)) dn.r = 0;
          fetchA(P, dn, kq, vq, qn, wid, lane); if (FINAL) fetchPart(P, dn, pp, pl, wid, lane); }
        const int qd = d.l0 + 32 * wid + r32; const int tok = d.tokb + qd * d.r;
        f32x16 o[2];
#pragma unroll
        for (int i = 0; i < 16; ++i) { o[0][i] = 0.f; o[1][i] = 0.f; }
        float lrun = 0.f;
#pragma unroll 1
        for (int hs = 0; hs < 5; ++hs) {
            const int hh = wid + hs, ks0 = d.l0 - 64 + 32 * hh;
            if (ks0 < 0 || ks0 >= d.seg) continue;
            att::TabCI ci; ci.tb = tab + (128 - (qd - ks0 - 4 * hi));
            att::half_step(Kb + (32 * hh + r32) * 128, so, Vb + (hh >> 1) * att::TILE_B + (hh & 1) * 2048, vo, qr, o, lrun, ci, att::NoPM{});
        }
        const float ltot = lrun + __shfl_xor(lrun, 32);
        if (!FINAL) {
            att::stage_o<true>(stg, o, 1.0f, r32, hi);
            prow = (bf16_t*)(P.ws + (d.cfg == 0 ? WS_PA1 : WS_PA4)) + (size_t)(d.tokb + (d.l0 + 32 * wid) * d.r) * 512 + d.h * 64; prstep = d.r * 512;
            pls = (float*)(P.ws + WS_LSE) + (size_t)d.cfg * M * 8 + (size_t)tok * 8 + d.h; plv = ltot;
        } else {
            const float inv = 1.0f / (ltot + plc[0] + plc[1]);
#pragma unroll
            for (int i = 0; i < 8; ++i) { const int d0 = i >> 2, gq = i & 3; const u32x2 a_ = pc[i], bq = pc[8 + i];
                o[d0][4 * gq] += bf_lo(a_.x) + bf_lo(bq.x); o[d0][4 * gq + 1] += bf_hi(a_.x) + bf_hi(bq.x); o[d0][4 * gq + 2] += bf_lo(a_.y) + bf_lo(bq.y); o[d0][4 * gq + 3] += bf_hi(a_.y) + bf_hi(bq.y); }
            att::stage_o<true>(stg, o, inv, r32, hi);
            prow = (bf16_t*)(P.ws + WS_AO) + (size_t)(d.tokb + (d.l0 + 32 * wid) * d.r) * D + d.h * 64; prstep = d.r * D;
        }
        LDS_WAIT(); __syncthreads();
    }
    if (prow) { att::flush_o<true>(stg, lane, [&](int row) { return prow + (size_t)row * prstep; }); if (!FINAL && hi == 0) *pls = plv; }
    __syncthreads();
}
template <bool FINAL>
__device__ __forceinline__ ADesc decodeH(int a) {
    ADesc d; const int cfg = FINAL ? 2 : (a >> 10), rem = a & 1023; d.cfg = cfg; d.b = rem >> 8; d.h = (rem >> 5) & 7; d.r = cfg == 0 ? 1 : (cfg == 1 ? 4 : 16);
    const int idx32 = rem & 31, nblk = 32 / d.r; d.p = idx32 / nblk; d.l0 = 128 * (idx32 % nblk); d.seg = SEQ / d.r; d.tokb = d.b * SEQ + d.p; return d; }
template <bool FINAL>
__device__ __forceinline__ void attnA_pc(const Ptrs& P, LAS unsigned char* lds, int afirst, int astep, int aend, int wid, int lane, int tid, int cfirst, int cstep) {
    constexpr int BUF = 8 * att::TILE_B, TAB0 = 2 * BUF, STG0 = TAB0 + 2048;
    static_assert(STG0 + 4 * att::OSTG <= MISC_OFF, "producer / consumer attention LDS map");
    if (afirst >= aend) return;
    const bf16_t* QKV = (const bf16_t*)(P.ws + WS_QKV);
    const float shift = __builtin_bit_cast(float, ((const volatile LAS unsigned*)(lds + MISC_OFF))[56]);
    if (wid >= 4) {
        const int pw = wid - 4, pt = tid - 256;
        auto stage_unit = [&](int a, int buf) {
            const ADesc d = decodeH<FINAL>(a); const bf16_t* Kg = QKV + (size_t)(8 + d.h) * M * 64; const bf16_t* Vg = QKV + (size_t)(16 + d.h) * M * 64;
            LAS unsigned char* Kb = lds + buf * BUF; LAS unsigned char* Vb = Kb + 4 * att::TILE_B;
#pragma unroll
            for (int t = 0; t < 4; ++t)
#pragma unroll
                for (int j = 0; j < 2; ++j) { const int v = 2 * pw + j;
                    int kd = d.l0 - 64 + 64 * t + 8 * v + (lane >> 3); kd = kd < 0 ? 0 : (kd > d.seg - 1 ? d.seg - 1 : kd);
                    int vd = d.l0 - 64 + 64 * t + 16 * (v & 3) + (lane >> 2); vd = vd < 0 ? 0 : (vd > d.seg - 1 ? d.seg - 1 : vd);
                    att::stage_tile(Kb + t * att::TILE_B, Vb + t * att::TILE_B, Kg, Vg, 64, d.tokb + kd * d.r, d.tokb + vd * d.r, v, lane); }
            const float cs = __builtin_amdgcn_exp2f(-(float)(2 * d.h + 1) * 0.5f) * (float)d.r * LOG2E;
            const float ad = fabsf((float)(128 - pt)); ((LAS float*)(lds + TAB0 + buf * 1024))[pt] = ad <= 64.f ? -cs * ad - shift : -INFINITY;
        };
        stage_unit(afirst, 0);
        VM_WAIT(); LDS_WAIT(); __syncthreads();
        f32x4 cv[16]; float cg[16]; int pend = -1, k = 0;
#pragma unroll 1
        for (int a = afirst; a < aend; a += astep, ++k) {
            if (pend >= 0) { const ConvItem c = p0_item(P, pend); convr_out8(cv, cg, c, lane); }
            pend = (cfirst >= 0 && k % cstep == 0 && k / cstep < 4) ? cfirst + pw * 4 + k / cstep : -1;
            if (pend >= 0) { const ConvItem c = p0_item(P, pend); convr_load(cv, cg, c, lane); }
            if (a + astep < aend) stage_unit(a + astep, (k + 1) & 1);
            VM_WAIT(); LDS_WAIT(); __syncthreads();
        }
        if (pend >= 0) { const ConvItem c = p0_item(P, pend); convr_out8(cv, cg, c, lane); }
    } else {
        const int r32 = lane & 31, hi = lane >> 5;
        LAS unsigned char* stg = lds + STG0 + wid * att::OSTG;
        unsigned so[4], vo[4];
        { const unsigned x = (unsigned)(r32 >> 1) & 7u;
#pragma unroll
          for (int d0 = 0; d0 < 4; ++d0) so[d0] = (((unsigned)(2 * d0 + hi)) ^ x) << 4;
          const unsigned vl = (unsigned)(((lane >> 4) & 1) * 32 + (lane & 3) * 8 + (4 * hi + ((lane & 15) >> 2)) * 64);
          vo[0] = vl; vo[1] = vl + 512u; vo[2] = vl + 1024u; vo[3] = vl + 1536u; }
        bf16x8 qn[4]; u32x2 pp[16]; float pl[2] = {0.f, 0.f};
        auto fetch_q = [&](int a) { const ADesc d = decodeH<FINAL>(a); const int tok = d.tokb + (d.l0 + 32 * wid + r32) * d.r;
#pragma unroll
            for (int d0 = 0; d0 < 4; ++d0) qn[d0] = *(const bf16x8*)(QKV + ((size_t)d.h * M + tok) * 64 + 16 * d0 + 8 * hi);
            if (FINAL) { const bf16_t* p1 = (const bf16_t*)(P.ws + WS_PA1) + (size_t)tok * 512 + d.h * 64; const bf16_t* p4 = (const bf16_t*)(P.ws + WS_PA4) + (size_t)tok * 512 + d.h * 64;
#pragma unroll
                for (int i = 0; i < 8; ++i) { const int c = 32 * (i >> 2) + 8 * (i & 3) + 4 * hi; pp[i] = *(const u32x2*)(p1 + c); pp[8 + i] = *(const u32x2*)(p4 + c); }
                const float* LS = (const float*)(P.ws + WS_LSE); pl[0] = LS[(size_t)tok * 8 + d.h]; pl[1] = LS[(size_t)M * 8 + (size_t)tok * 8 + d.h]; } };
        fetch_q(afirst);
        __syncthreads();
        int k = 0;
#pragma unroll 1
        for (int a = afirst; a < aend; a += astep, ++k) {
            const ADesc d = decodeH<FINAL>(a);
            bf16x8 qr[4];
#pragma unroll
            for (int d0 = 0; d0 < 4; ++d0) qr[d0] = qn[d0];
            u32x2 pc[16]; float plc[2];
            if (FINAL) {
#pragma unroll
                for (int i = 0; i < 16; ++i) pc[i] = pp[i];
                plc[0] = pl[0]; plc[1] = pl[1]; }
            fetch_q(a + astep < aend ? a + astep : a);
            const LAS unsigned char* Kb = lds + (k & 1) * BUF; const LAS unsigned char* Vb = Kb + 4 * att::TILE_B; const LAS float* tab = (const LAS float*)(lds + TAB0 + (k & 1) * 1024);
            const int qd = d.l0 + 32 * wid + r32; const int tok = d.tokb + qd * d.r;
            f32x16 o[2];
#pragma unroll
            for (int i = 0; i < 16; ++i) { o[0][i] = 0.f; o[1][i] = 0.f; }
            float lrun = 0.f;
#pragma unroll 1
            for (int hs = 0; hs < 5; ++hs) {
                const int hh = wid + hs, ks0 = d.l0 - 64 + 32 * hh;
                if (ks0 < 0 || ks0 >= d.seg) continue;
                att::TabCI ci; ci.tb = tab + (128 - (qd - ks0 - 4 * hi));
                att::half_step(Kb + (32 * hh + r32) * 128, so, Vb + (hh >> 1) * att::TILE_B + (hh & 1) * 2048, vo, qr, o, lrun, ci, att::NoPM{});
            }
            const float ltot = lrun + __shfl_xor(lrun, 32);
            bf16_t* prow; int prstep;
            if (!FINAL) {
                att::stage_o<true>(stg, o, 1.0f, r32, hi);
                prow = (bf16_t*)(P.ws + (d.cfg == 0 ? WS_PA1 : WS_PA4)) + (size_t)(d.tokb + (d.l0 + 32 * wid) * d.r) * 512 + d.h * 64; prstep = d.r * 512;
                if (hi == 0) ((float*)(P.ws + WS_LSE))[(size_t)d.cfg * M * 8 + (size_t)tok * 8 + d.h] = ltot;
            } else {
                const float inv = 1.0f / (ltot + plc[0] + plc[1]);
#pragma unroll
                for (int i = 0; i < 8; ++i) { const int d0 = i >> 2, gq = i & 3; const u32x2 a_ = pc[i], bq = pc[8 + i];
                    o[d0][4 * gq] += bf_lo(a_.x) + bf_lo(bq.x); o[d0][4 * gq + 1] += bf_hi(a_.x) + bf_hi(bq.x); o[d0][4 * gq + 2] += bf_lo(a_.y) + bf_lo(bq.y); o[d0][4 * gq + 3] += bf_hi(a_.y) + bf_hi(bq.y); }
                att::stage_o<true>(stg, o, inv, r32, hi);
                prow = (bf16_t*)(P.ws + WS_AO) + (size_t)(d.tokb + (d.l0 + 32 * wid) * d.r) * D + d.h * 64; prstep = d.r * D;
            }
            LDS_WAIT();
            att::flush_o<true>(stg, lane, [&](int row) { return prow + (size_t)row * prstep; });
            LDS_WAIT(); __syncthreads();
        }
    }
    __syncthreads();
}
__device__ __forceinline__ void fetchB(const Ptrs& P, int u, int rr, u32x4 (&kq)[5], u32x4 (&vq)[5], bf16x8 (&qn)[4], int wid, int lane) {
    const int b = u >> 7, kvh = (u >> 6) & 1, q0 = 64 * (u & 63), tokb = b * SEQ;
    const bf16_t* QKV = (const bf16_t*)(P.ws + WS_QKV); const bf16_t* Kg = QKV + (size_t)(32 + kvh) * M * 64; const bf16_t* Vg = QKV + (size_t)(34 + kvh) * M * 64;
#pragma unroll
    for (int t = 0; t < 5; ++t) {
        int kd = q0 - 128 + 64 * t + 8 * wid + (lane >> 3); kd = kd < 0 ? 0 : (kd > SEQ - 1 ? SEQ - 1 : kd);
        int vd = q0 - 128 + 64 * t + 16 * (wid & 3) + (lane >> 2); vd = vd < 0 ? 0 : (vd > SEQ - 1 ? SEQ - 1 : vd);
        att::fetch_tile(kq[t], vq[t], Kg, Vg, 64, tokb + kd * rr, tokb + vd * rr, wid, lane); }
    const int hq = 4 * kvh + (wid & 3), tok = tokb + (q0 + 32 * (wid >> 2) + (lane & 31)) * rr;
#pragma unroll
    for (int d0 = 0; d0 < 4; ++d0) qn[d0] = *(const bf16x8*)(QKV + ((size_t)(24 + hq) * M + tok) * 64 + 16 * d0 + 8 * (lane >> 5));
}
__device__ __forceinline__ void attnB_run(const Ptrs& P, LAS unsigned char* lds, int ufirst, int ustep, int uend, int wid, int lane, int tid) {
    const int r32 = lane & 31, hi = lane >> 5;
    LAS unsigned char* Kb = lds; LAS unsigned char* Vb = lds + 5 * att::TILE_B; LAS float* tab = (LAS float*)(lds + 10 * att::TILE_B);
    LAS unsigned char* stg = lds + 10 * att::TILE_B + 6144 + wid * att::OSTG;
    if (ufirst >= uend) return;
    const float shift = __builtin_bit_cast(float, ((const volatile LAS unsigned*)(lds + MISC_OFF))[57]);
    unsigned so[4], vo[4];
    { const unsigned x = (unsigned)(r32 >> 1) & 7u;
#pragma unroll
      for (int d0 = 0; d0 < 4; ++d0) so[d0] = (((unsigned)(2 * d0 + hi)) ^ x) << 4;
      const unsigned vl = (unsigned)(((lane >> 4) & 1) * 32 + (lane & 3) * 8 + (4 * hi + ((lane & 15) >> 2)) * 64);
      vo[0] = vl; vo[1] = vl + 512u; vo[2] = vl + 1024u; vo[3] = vl + 1536u; }
    u32x4 kq[5], vq[5]; bf16x8 qn[4];
    const float sink0 = __builtin_amdgcn_exp2f(P.in[7][wid & 3] * LOG2E - shift), sink1 = __builtin_amdgcn_exp2f(P.in[7][4 + (wid & 3)] * LOG2E - shift);
    fetchB(P, ufirst, 1, kq, vq, qn, wid, lane);
    bf16_t* prow = nullptr;
#pragma unroll 1
    for (int u = ufirst; u < uend; u += ustep) {
        const int b = u >> 7, kvh = (u >> 6) & 1, q0 = 64 * (u & 63), tokb = b * SEQ;
#pragma unroll
        for (int t = 0; t < 5; ++t) att::commit_tile(Kb + t * att::TILE_B, Vb + t * att::TILE_B, kq[t], vq[t], wid, lane);
        bf16x8 qr[4];
#pragma unroll
        for (int d0 = 0; d0 < 4; ++d0) qr[d0] = qn[d0];
#pragma unroll
        for (int i = 0; i < 3; ++i) { const int e = tid + 512 * i, hd_ = e / 384, y = e - hd_ * 384; const float ad = fabsf((float)(192 - y));
            const float csl = __builtin_amdgcn_exp2f(-(float)(4 * kvh + hd_ + 1)) * LOG2E;
            tab[e] = ad <= 128.f ? -csl * ad - shift : -INFINITY; }
        const int hd = wid & 3, hq = 4 * kvh + hd; const int qd = q0 + 32 * (wid >> 2) + r32;
        const float sinkp = kvh ? sink1 : sink0;
        LDS_WAIT(); __syncthreads();
        if (prow) att::flush_o<true>(stg, lane, [&](int row) { return prow + (size_t)row * D; });
        fetchB(P, u + ustep < uend ? u + ustep : u, u + ustep < uend ? 1 : 0, kq, vq, qn, wid, lane);
        f32x16 o[2];
#pragma unroll
        for (int i = 0; i < 16; ++i) { o[0][i] = 0.f; o[1][i] = 0.f; }
        float lrun = hi == 0 ? sinkp : 0.f;
#pragma unroll 1
        for (int hs = 0; hs < 9; ++hs) {
            const int hh = (wid >> 2) + hs, ks0 = q0 - 128 + 32 * hh;
            if (ks0 < 0 || ks0 >= SEQ) continue;
            att::TabCI ci; ci.tb = tab + hd * 384 + (192 - (qd - ks0 - 4 * hi));
            att::half_step(Kb + (32 * hh + r32) * 128, so, Vb + (hh >> 1) * att::TILE_B + (hh & 1) * 2048, vo, qr, o, lrun, ci, att::NoPM{});
        }
        const float ltot = lrun + __shfl_xor(lrun, 32);
        att::stage_o<true>(stg, o, 1.0f / ltot, r32, hi);
        prow = (bf16_t*)(P.ws + WS_AO) + (size_t)(tokb + q0 + 32 * (wid >> 2)) * D + 512 + hq * 64;
        LDS_WAIT(); __syncthreads();
    }
    if (prow) att::flush_o<true>(stg, lane, [&](int row) { return prow + (size_t)row * D; });
    __syncthreads();
}
__device__ __forceinline__ void attnC_column(const Ptrs& P, LAS unsigned char* lds, int b, int h, int ip0, int nip, int wid, int lane, int tid, int cfirst) {
    const int r32 = lane & 31, hi = lane >> 5;
    const bf16_t* QKV = (const bf16_t*)(P.ws + WS_QKV);
    const bf16_t* Kg = QKV + (size_t)(16 + h) * M * 64; const bf16_t* Vg = QKV + (size_t)(32 + h) * M * 64;
    const int tokb = b * SEQ;
    LAS unsigned char* Kb = lds; LAS unsigned char* Vb = lds + 9 * att::TILE_B; LAS float* tab = (LAS float*)(lds + RPB_OFF);
    const float shift = __builtin_bit_cast(float, ((const volatile LAS unsigned*)(lds + MISC_OFF))[58]);
#pragma unroll
    for (int i = 0; i < 2; ++i) { const int e = tid + 512 * i, row = e >> 6, co = (e & 63) - 16;
        tab[e] = (row < 15 && co >= 0 && co < 31) ? P.in[17][(size_t)h * 465 + row * 31 + co] * LOG2E - shift : -INFINITY; }
    int have;
    { const int i0 = 2 * ip0; const int rs0 = i0 - 4 < 0 ? 0 : (i0 - 4 > 56 ? 56 : i0 - 4); const int last = rs0 + 8 > 63 ? 63 : rs0 + 8;
#pragma unroll 1
      for (int kr = rs0; kr <= last; ++kr) { const int sl = kr % 9;
          att::stage_tile(Kb + sl * att::TILE_B, Vb + sl * att::TILE_B, Kg, Vg, 64, tokb + kr * 64 + 8 * wid + (lane >> 3), tokb + kr * 64 + 16 * (wid & 3) + (lane >> 2), wid, lane); }
      have = last; }
    u32x4 kn[2], vn[2]; int nnew = 0, newrow = 0;
#define ATTC_COMMIT() do { if (nnew > 0) att::commit_tile(Kb + (newrow % 9) * att::TILE_B, Vb + (newrow % 9) * att::TILE_B, kn[0], vn[0], wid, lane); \
        if (nnew > 1) att::commit_tile(Kb + ((newrow + 1) % 9) * att::TILE_B, Vb + ((newrow + 1) % 9) * att::TILE_B, kn[1], vn[1], wid, lane); } while (0)
#define ATTC_FETCH(i0_) do { nnew = 0; if (s + 1 < nip) { const int i1_ = (i0_) + 2; const int rs1_ = i1_ - 4 < 0 ? 0 : (i1_ - 4 > 56 ? 56 : i1_ - 4); const int last1_ = rs1_ + 8 > 63 ? 63 : rs1_ + 8; \
        nnew = last1_ - have; newrow = have + 1; \
        if (nnew > 0) att::fetch_tile(kn[0], vn[0], Kg, Vg, 64, tokb + newrow * 64 + 8 * wid + (lane >> 3), tokb + newrow * 64 + 16 * (wid & 3) + (lane >> 2), wid, lane); \
        if (nnew > 1) att::fetch_tile(kn[1], vn[1], Kg, Vg, 64, tokb + (newrow + 1) * 64 + 8 * wid + (lane >> 3), tokb + (newrow + 1) * 64 + 16 * (wid & 3) + (lane >> 2), wid, lane); \
        have = last1_; } } while (0)
    if (wid >= 4) {
        f32x4 cv[16], cw[16]; float cg[16], ch[16]; int pa = -1, pb = -1;
        VM_WAIT();
#pragma unroll 1
        for (int s = 0; s < nip; ++s) {
            const int i0 = 2 * (ip0 + s);
            ATTC_COMMIT();
            LDS_WAIT(); __syncthreads();
            ATTC_FETCH(i0);
            if (pa >= 0) { const ConvItem c = p0_item(P, pa); convr_out8(cv, cg, c, lane); }
            if (pb >= 0) { const ConvItem c = p0_item(P, pb); convr_out8(cw, ch, c, lane); }
            if (P0_C_PER_WAVE <= 8) { pa = (cfirst >= 0 && s < P0_C_PER_WAVE) ? cfirst + (wid - 4) * P0_C_PER_WAVE + s : -1; pb = -1; }
            else { pa = (cfirst >= 0 && 2 * s < P0_C_PER_WAVE) ? cfirst + (wid - 4) * P0_C_PER_WAVE + 2 * s : -1;
                   pb = (cfirst >= 0 && 2 * s + 1 < P0_C_PER_WAVE) ? cfirst + (wid - 4) * P0_C_PER_WAVE + 2 * s + 1 : -1; }
            if (pa >= 0) { const ConvItem c = p0_item(P, pa); convr_load(cv, cg, c, lane); }
            if (pb >= 0) { const ConvItem c = p0_item(P, pb); convr_load(cw, ch, c, lane); }
            __syncthreads();
        }
        if (pa >= 0) { const ConvItem c = p0_item(P, pa); convr_out8(cv, cg, c, lane); }
        if (pb >= 0) { const ConvItem c = p0_item(P, pb); convr_out8(cw, ch, c, lane); }
    } else {
    LAS unsigned char* stg = lds + OSTAGE_OFF + (wid & 3) * 2560;
    const int cb = wid & 3;
    const int j = 16 * cb + (r32 & 15);
    const int cs0 = j - 8 < 0 ? 0 : (j - 8 > 48 ? 48 : j - 8);
    const int kcol0 = 16 * cb - 8 < 0 ? 0 : (16 * cb - 8 > 32 ? 32 : 16 * cb - 8);
    const int wm = (int)((0xFFFFu << (cs0 - kcol0)) >> (4 * hi));
    unsigned so[4], vo[4];
    { const unsigned x = (unsigned)((kcol0 + r32) >> 1) & 7u;
#pragma unroll
      for (int d0 = 0; d0 < 4; ++d0) so[d0] = (((unsigned)(2 * d0 + hi)) ^ x) << 4;
      const unsigned colb = (unsigned)(((lane >> 4) & 1) * 32 + (lane & 3) * 8);
#pragma unroll
      for (int m = 0; m < 4; ++m) { const int k = kcol0 + 8 * m + 4 * hi + ((lane & 15) >> 2); vo[m] = (unsigned)(((k >> 4) & 3) * 1024 + (k & 15) * 64) + colb; } }
    const int tb0 = kcol0 + 4 * hi - j + 31;
    bf16x8 qn[4];
    { const int tok = tokb + (2 * ip0 + (r32 >> 4)) * 64 + j;
#pragma unroll
      for (int d0 = 0; d0 < 4; ++d0) qn[d0] = *(const bf16x8*)(QKV + ((size_t)h * M + tok) * 64 + 16 * d0 + 8 * hi); }
    u32x2 opk[8]; bf16_t* prow = nullptr;
    VM_WAIT();
#pragma unroll 1
    for (int s = 0; s < nip; ++s) {
        const int i0 = 2 * (ip0 + s);
        const int rs0 = i0 - 4 < 0 ? 0 : (i0 - 4 > 56 ? 56 : i0 - 4);
        ATTC_COMMIT();
        bf16x8 qr[4];
#pragma unroll
        for (int d0 = 0; d0 < 4; ++d0) qr[d0] = qn[d0];
        LDS_WAIT(); __syncthreads();
        if (prow) {
#pragma unroll
            for (int d0 = 0; d0 < 2; ++d0) {
#pragma unroll
                for (int gq = 0; gq < 4; ++gq) *(LAS u32x2*)(stg + r32 * 80 + (8 * gq + 4 * hi) * 2) = opk[4 * d0 + gq];
                LDS_WAIT();
#pragma unroll
                for (int i = 0; i < 2; ++i) { const int row = i * 16 + (lane >> 2), ch = lane & 3; const u32x4 v = *(const LAS u32x4*)(stg + row * 80 + ch * 16);
                    *(u32x4*)(prow + (size_t)((row >> 4) * 64 + (row & 15)) * D + 32 * d0 + ch * 8) = v; }
                LDS_WAIT();
            }
        }
        ATTC_FETCH(i0);
        if (s + 1 < nip) {
            const int tok1 = tokb + (i0 + 2 + (r32 >> 4)) * 64 + j;
#pragma unroll
            for (int d0 = 0; d0 < 4; ++d0) qn[d0] = *(const bf16x8*)(QKV + ((size_t)h * M + tok1) * 64 + 16 * d0 + 8 * hi);
        }
        {
            const int qi = i0 + (r32 >> 4);
            f32x16 o[2];
#pragma unroll
            for (int q = 0; q < 16; ++q) { o[0][q] = 0.f; o[1][q] = 0.f; }
            float lrun = 0.f;
            const int rsi = qi - 4 < 0 ? 0 : (qi - 4 > 56 ? 56 : qi - 4);
            att::pipe_rows<9, true>([&](int t) { const int kr = rs0 + t; const int sl = kr % 9; const bool rowok = kr >= rsi && kr <= rsi + 7; const int ro = rowok ? kr - qi + 7 : 15;
                    att::HS hs; hs.ka = Kb + (sl * 64 + kcol0 + r32) * 128; hs.vb = Vb + sl * att::TILE_B; hs.tb = tab + ro * 64 + tb0; return hs; }, so, vo, qr, o, lrun, wm);
            const float inv = 1.0f / (lrun + __shfl_xor(lrun, 32));
#pragma unroll
            for (int i = 0; i < 8; ++i) { const int d0 = i >> 2, gq = i & 3; opk[i].x = cvt_pk_bf16(o[d0][4 * gq] * inv, o[d0][4 * gq + 1] * inv); opk[i].y = cvt_pk_bf16(o[d0][4 * gq + 2] * inv, o[d0][4 * gq + 3] * inv); }
            prow = (bf16_t*)(P.ws + WS_AO) + (size_t)(tokb + i0 * 64 + 16 * cb) * D + h * 64;
        }
        __syncthreads();
    }
    if (prow) {
#pragma unroll
        for (int d0 = 0; d0 < 2; ++d0) {
#pragma unroll
            for (int gq = 0; gq < 4; ++gq) *(LAS u32x2*)(stg + r32 * 80 + (8 * gq + 4 * hi) * 2) = opk[4 * d0 + gq];
            LDS_WAIT();
#pragma unroll
            for (int i = 0; i < 2; ++i) { const int row = i * 16 + (lane >> 2), ch = lane & 3; const u32x4 v = *(const LAS u32x4*)(stg + row * 80 + ch * 16);
                *(u32x4*)(prow + (size_t)((row >> 4) * 64 + (row & 15)) * D + 32 * d0 + ch * 8) = v; }
            LDS_WAIT();
        }
    }
    }
#undef ATTC_COMMIT
#undef ATTC_FETCH
    __syncthreads();
}

__device__ __forceinline__ void route_phase(const Ptrs& P, LAS unsigned char* lds, gu32* ctl, int bx, int G, int wave, int lane, int tid) {
    LAS float* wl = (LAS float*)lds;
    LAS unsigned* lc = (LAS unsigned*)(lds + 32768);
    LAS unsigned* rec = (LAS unsigned*)(lds + 32768 + 64);
    for (int i = tid; i < D * NE; i += NWAVES * 64) { const int k = i >> 3; wl[(((k >> 9) * 8 + (k & 7)) * 64 + ((k >> 3) & 63)) * 8 + (i & 7)] = P.in[20][i] * P.in[19][k]; }
    if (tid < 16) lc[tid] = 0u;
    __syncthreads();
    unsigned* rowtok = (unsigned*)(P.ws + WS_ROWTOK); float* rowgate = (float*)(P.ws + WS_ROWGATE); float* rowrs = (float*)(P.ws + WS_ROWRS);
    f32x4 wreg[2][8][2];
#pragma unroll
    for (int jj = 0; jj < 2; ++jj)
#pragma unroll
        for (int c = 0; c < 8; ++c) { const LAS f32x4* w = (const LAS f32x4*)(wl + (size_t)((jj * 8 + c) * 64 + lane) * 8); wreg[jj][c][0] = w[0]; wreg[jj][c][1] = w[1]; }
    for (int ch = bx; ch < M / 64; ch += G) {
        u32x4 xrow[8][2];
#pragma unroll
        for (int t = 0; t < 8; ++t) { const u32x4* xr = (const u32x4*)((const bf16_t*)(P.ws + WS_XB) + (size_t)(ch * 64 + wave * 8 + t) * D) + lane; xrow[t][0] = xr[0]; xrow[t][1] = xr[64]; }
#pragma unroll
        for (int t = 0; t < 8; ++t) {
            const int m = ch * 64 + wave * 8 + t;
            float s = 0.f; float a[8];
#pragma unroll
            for (int e = 0; e < 8; ++e) a[e] = 0.f;
#pragma unroll
            for (int jj = 0; jj < 2; ++jj) { const u32x4 xw = xrow[t][jj]; const float xv[8] = {bf_lo(xw.x), bf_hi(xw.x), bf_lo(xw.y), bf_hi(xw.y), bf_lo(xw.z), bf_hi(xw.z), bf_lo(xw.w), bf_hi(xw.w)};
                { int w0 = 0, w1 = 0;
                  float c8[8];
#pragma unroll
                  for (int q = 0; q < 8; ++q) c8[q] = __builtin_amdgcn_fmed3f(xv[q] * X8_SCALE, -448.f, 448.f);
                  w0 = __builtin_amdgcn_cvt_pk_fp8_f32(c8[0], c8[1], w0, false); w0 = __builtin_amdgcn_cvt_pk_fp8_f32(c8[2], c8[3], w0, true);
                  w1 = __builtin_amdgcn_cvt_pk_fp8_f32(c8[4], c8[5], w1, false); w1 = __builtin_amdgcn_cvt_pk_fp8_f32(c8[6], c8[7], w1, true);
                  u32x2 w8; w8.x = (unsigned)w0; w8.y = (unsigned)w1; *((u32x2*)(P.ws + WS_XB8 + (size_t)m * D) + 64 * jj + lane) = w8; }
#pragma unroll
                for (int c = 0; c < 8; ++c) { const f32x4 w0 = wreg[jj][c][0], w1 = wreg[jj][c][1]; const float x_ = xv[c]; s += x_ * x_;
                    a[0] += x_ * w0.x; a[1] += x_ * w0.y; a[2] += x_ * w0.z; a[3] += x_ * w0.w; a[4] += x_ * w1.x; a[5] += x_ * w1.y; a[6] += x_ * w1.z; a[7] += x_ * w1.w; } }
            s = wave_sum(s);
#pragma unroll
            for (int e = 0; e < 8; ++e) a[e] = wave_sum(a[e]);
            if (lane == 0) {
                const float rs = rsqrtf(s * (1.0f / D) + EPS);
                int e1 = 0; float v1 = a[0];
#pragma unroll
                for (int e = 1; e < 8; ++e) if (a[e] > v1) { v1 = a[e]; e1 = e; }
                int e2 = e1 == 0 ? 1 : 0; float v2 = e1 == 0 ? a[1] : a[0];
#pragma unroll
                for (int e = 1; e < 8; ++e) if (e != e1 && a[e] > v2) { v2 = a[e]; e2 = e; }
                const float g1 = 1.0f / (1.0f + __expf((v2 - v1) * rs)), g2 = 1.0f - g1;
                const unsigned s1 = __hip_atomic_fetch_add(lc + e1, 1u, __ATOMIC_RELAXED, __HIP_MEMORY_SCOPE_WORKGROUP);
                const unsigned s2 = __hip_atomic_fetch_add(lc + e2, 1u, __ATOMIC_RELAXED, __HIP_MEMORY_SCOPE_WORKGROUP);
                LAS unsigned* r = rec + (wave * 8 + t) * 4;
                r[0] = (unsigned)e1 | ((unsigned)e2 << 8) | (s1 << 16) | (s2 << 24); r[1] = __builtin_bit_cast(unsigned, rs); r[2] = __builtin_bit_cast(unsigned, g1); r[3] = __builtin_bit_cast(unsigned, g2);
            }
        }
        __syncthreads();
        if (tid < 8) lc[8 + tid] = __hip_atomic_fetch_add((unsigned*)(ctl + CW_CNT + 64 * tid), lc[tid], RLX_AGENT);
        __syncthreads();
        if (tid < 64) { const LAS unsigned* r = rec + tid * 4; const unsigned ee = r[0]; const int e1 = ee & 255u, e2 = (ee >> 8) & 255u; const unsigned m = (unsigned)(ch * 64 + tid);
            const unsigned p1 = lc[8 + e1] + ((ee >> 16) & 255u), p2 = lc[8 + e2] + (ee >> 24); const float rsv = __builtin_bit_cast(float, r[1]);
            rowtok[(size_t)e1 * CAP + p1] = m; rowgate[(size_t)e1 * CAP + p1] = __builtin_bit_cast(float, r[2]); rowrs[(size_t)e1 * CAP + p1] = rsv;
            rowtok[(size_t)e2 * CAP + p2] = m | 0x80000000u; rowgate[(size_t)e2 * CAP + p2] = __builtin_bit_cast(float, r[3]); rowrs[(size_t)e2 * CAP + p2] = rsv; }
        __syncthreads();
        if (tid < 8) lc[tid] = 0u;
        __syncthreads();
    }
}
#ifndef MK_N_LAUNCHES
#define MK_N_LAUNCHES 1
#endif
constexpr int N_PHASES = 14;
constexpr int N_LAUNCHES = MK_N_LAUNCHES;
static_assert(N_LAUNCHES == 1 || N_LAUNCHES == N_PHASES, "MK_N_LAUNCHES is 1 or 14");


__global__ void __launch_bounds__(NWAVES * 64, 2) fwd(Args args) {
    extern __shared__ __attribute__((aligned(16))) unsigned char lds_raw[];
    LAS unsigned char* lds = (LAS unsigned char*)lds_raw;
    volatile LAS unsigned* MISC = (volatile LAS unsigned*)(lds + MISC_OFF);
    const int tid = threadIdx.x, lane = tid & 63, wave = __builtin_amdgcn_readfirstlane(tid >> 6);
#define PHASE_IDS int tid_p_ = threadIdx.x; asm volatile("" : "+v"(tid_p_)); const int tid = tid_p_, lane = tid_p_ & 63; (void)tid; (void)lane
    const int G = gridDim.x, bx = blockIdx.x;
    const int gw = bx * NWAVES + wave, NGW = G * NWAVES;
    const int vcu = (G % 8 == 0) ? (bx % 8) * (G / 8) + bx / 8 : bx;
    const Args& P = args;
    unsigned char* ws = args.ws;
    gu32* ctl = (gu32*)(ws + WS_CTL);
    if (tid < 192) MISC[tid] = 0u;
    __syncthreads();
    if (wave < 3) { const int gi = wave == 0 ? 3 : (wave == 1 ? 5 : 15); const float bnd = att::qk_bound(args.in[gi], args.in[gi + 1], lane); if (lane == 0) MISC[56 + wave] = __builtin_bit_cast(unsigned, bnd); }
    XcdBarrier bar; bar.bar = (unsigned*)(ctl + CW_BAR); bar.x = 0; bar.st = nullptr;
    if (N_LAUNCHES == 1) bar = xcd_barrier_post((unsigned*)(ctl + CW_BAR), MISC + 8);
#define GRID_BAR() do { if (N_LAUNCHES == 1) xcd_barrier(bar); } while (0)
    const int lo = args.ph_lo, hi = args.ph_hi;
#ifndef PH_MASK
#define PH_MASK 0x3fff
#endif
#define IN(k) ((((PH_MASK) >> (k)) & 1) && (N_LAUNCHES == 1 || (lo <= (k) && (k) < hi)))
#define BOTH(k) (IN(k) && IN((k) + 1))
    bf16_t* XB = (bf16_t*)(ws + WS_XB); bf16_t* QKV = (bf16_t*)(ws + WS_QKV); bf16_t* AO = (bf16_t*)(ws + WS_AO);
    float* SS = (float*)(ws + WS_SS);
    const volatile LAS int* T = (const volatile LAS int*)(MISC + 16);

    if (IN(0)) { PHASE_IDS; p0_prologue(P, lds, gw, NGW, wave, lane, G); if (BOTH(0)) GRID_BAR(); }
    if (IN(1)) { PHASE_IDS;
        pg8::Gemm g{XB, (const bf16_t*)(ws + WS_WIN), D}; pg8::DenseOrder S; S.init(M, N_IN0, D, G, bx);
        if (tid < 256) ((LAS float*)(lds + GN_OFF))[tid] = P.in[3 + (tid >> 6)][tid & 63];
        pg8::EpiQKV E{QKV, N_IN0, SS, 0};
        pg8::gemm_phase(lds, g, S, E);
        if (G == 256 && bx >= 64) p0_tail_items(P, lds, P0_ITEMS - P0_DEFER + ((bx - 64) * NWAVES + wave) * 3, 3, wave, lane);
        if (BOTH(1)) GRID_BAR();
    }
    if (IN(2)) { PHASE_IDS;
        attnB_run(P, lds, vcu, G, 512, wave, lane, tid);
        if (G == 256) attnA_pc<false>(P, lds, vcu, G, 2048, wave, lane, tid, P0_ITEMS - P0_DEFER - P0_DEFER_C - P0_DEFER_H - P0_DEFER_F + bx * 16, 2);
        else attnA_run<false>(P, lds, vcu, G, 1024, wave, lane, tid);
        if (BOTH(2)) GRID_BAR();
    }
    if (IN(3)) { PHASE_IDS;
        if (G == 256) attnA_pc<true>(P, lds, vcu, G, 1024, wave, lane, tid, P0_ITEMS - P0_DEFER - P0_DEFER_C - P0_DEFER_H + bx * 16, 1);
        else attnA_run<true>(P, lds, vcu, G, 512, wave, lane, tid);
        if (BOTH(3)) GRID_BAR();
    }
    if (IN(4)) { PHASE_IDS;
        pg8::Gemm g{AO, (const bf16_t*)(ws + WS_WOUT0), D}; pg8::DenseOrder S; S.init(M, D, D, G, bx);
        pg8::EpiRes E{XB, SS + (size_t)1 * M * 4, XB};
        pg8::gemm_phase(lds, g, S, E);
        if (BOTH(4)) GRID_BAR();
    }
    if (IN(5)) { PHASE_IDS;
        pg8::Gemm g{XB, (const bf16_t*)(ws + WS_WGU0), D}; pg8::DenseOrder S; S.init(M, 2 * FF0, D, G, bx);
        pg8::EpiSwi<false> E{(bf16_t*)(ws + WS_H0), FF0, SS + (size_t)1 * M * 4, nullptr, T};
        pg8::gemm_phase(lds, g, S, E);
        if (G == 256 && bx >= 128) p0_tail_items(P, lds, P0_ITEMS - P0_DEFER_B + ((bx - 128) * NWAVES + wave) * 3, 3, wave, lane);
        if (BOTH(5)) GRID_BAR();
    }
    if (IN(6)) { PHASE_IDS;
        pg8::Gemm g{(const bf16_t*)(ws + WS_H0), (const bf16_t*)(ws + WS_WD0), FF0}; pg8::DenseOrder S; S.init(M, D, FF0, G, bx);
        pg8::EpiRes E{XB, SS + (size_t)2 * M * 4, XB};
        pg8::gemm_phase(lds, g, S, E);
        if (BOTH(6)) GRID_BAR();
    }
    if (IN(7)) { PHASE_IDS;
        pg8::Gemm g{XB, (const bf16_t*)(ws + WS_WQKV1), D}; pg8::DenseOrder S; S.init(M, N_QKV1, D, G, bx);
        if (tid < 128) ((LAS float*)(lds + GN_OFF))[tid] = P.in[15 + (tid >> 6)][tid & 63];
        pg8::EpiQKV E{QKV, N_QKV1, SS + (size_t)2 * M * 4, 1};
        pg8::gemm_phase(lds, g, S, E);
        if (BOTH(7)) GRID_BAR();
    }
    if (IN(8)) { PHASE_IDS;
        for (int w = vcu; w < 256; w += G) attnC_column(P, lds, w >> 6, (w >> 2) & 15, 8 * (w & 3), 8, wave, lane, tid, G == 256 ? P0_ITEMS - P0_DEFER - P0_DEFER_C + w * 4 * P0_C_PER_WAVE : -1);
        if (BOTH(8)) GRID_BAR();
    }
    if (IN(9)) { PHASE_IDS;
        pg8::Gemm g{AO, (const bf16_t*)(ws + WS_WOUT1), D}; pg8::DenseOrder S; S.init(M, D, D, G, bx);
        pg8::EpiRes E{XB, SS + (size_t)3 * M * 4, XB};
        pg8::gemm_phase(lds, g, S, E);
        if (BOTH(9)) GRID_BAR();
    }
    if (IN(10)) { PHASE_IDS; route_phase(P, lds, ctl, bx, G, wave, lane, tid); if (BOTH(10)) GRID_BAR(); }
    if (IN(11) || IN(12)) { PHASE_IDS;
        if (tid < 8) MISC[16 + tid] = __hip_atomic_load((unsigned*)(ctl + CW_CNT + 64 * tid), RLX_AGENT);
        __syncthreads();
        if (tid == 0) { int t0 = 0, r0 = 0, x = 0;
            for (int e = 0; e < 8; ++e) { const int c = (int)MISC[16 + e]; const int nt = (c + 255) >> 8;
                MISC[16 + e] = (unsigned)c; MISC[24 + e] = (unsigned)t0; MISC[35 + e] = (unsigned)r0; t0 += nt; r0 += nt < 16 ? nt : 16;
                for (int l = 16; l < nt; ++l) { if (x < 9) MISC[44 + x] = (unsigned)((e << 8) | l); ++x; } }
            MISC[32] = (unsigned)(t0 > MAXT ? MAXT : t0); MISC[43] = (unsigned)r0; MISC[33] = (unsigned)x;
            MISC[34] = (x >= 1 && x <= 9 && 28 * x <= G && 8 * x <= G && t0 <= MAXT) ? 1u : 0u; }
        __syncthreads();
    }
    const bool fast = T[18] != 0;
    volatile LAS unsigned* UL = (volatile LAS unsigned*)(lds + ULIST_OFF);
    LAS unsigned* TOKL = (LAS unsigned*)(lds + EPI_OFF);
    if (IN(11)) { PHASE_IDS;
        pg8::Gemm g{(const bf16_t*)(ws + WS_XB8), (const bf16_t*)(ws + WS_WGUE), D / 2};
        pg8::EpiSwi<true> E{(bf16_t*)(ws + WS_HM), FFE, nullptr, (const float*)(ws + WS_ROWRS), T};
        if (fast) {
            { pg8::moe_build_list<1>(UL, T, 2 * FFE / 256, G, bx, 1, tid, (const unsigned*)(ws + WS_ROWTOK), TOKL); pg8::ListOrder S; S.init(UL, T, 2 * FFE, D / 2, 1, (const unsigned*)(ws + WS_ROWTOK), TOKL); pg8::gemm_phase(lds, g, S, E); }
            if (tid == 0) { __builtin_amdgcn_fence(__ATOMIC_RELEASE, "agent"); asm volatile("s_waitcnt vmcnt(0)" ::: "memory"); __hip_atomic_fetch_add((unsigned*)(ctl + CW_CA), 1u, RLX_AGENT); }
            if (bx < 4 * T[17]) {
                if (tid == 0) { unsigned sp = 0; while (__hip_atomic_load((unsigned*)(ctl + CW_CA), RLX_AGENT) < (unsigned)G && ++sp < (1u << 22)) __builtin_amdgcn_s_sleep(2);
                    __builtin_amdgcn_fence(__ATOMIC_ACQUIRE, "agent"); asm volatile("s_waitcnt vmcnt(0)" ::: "memory"); }
                __syncthreads();
                pg8::Gemm gd{(const bf16_t*)(ws + WS_HM), (const bf16_t*)(ws + WS_WDE), FFE / 2}; pg8::moe_build_list<3>(UL, T, D / 256, G, bx, 1, tid, nullptr, TOKL); pg8::ListOrder Sd; Sd.init(UL, T, D, FFE / 2, 0, nullptr, TOKL);
                pg8::EpiMoeDown Ed{(bf16_t*)(ws + WS_Y1), (bf16_t*)(ws + WS_Y2), (bf16_t*)(ws + WS_Y2X), (const unsigned*)(ws + WS_ROWTOK), (const float*)(ws + WS_ROWGATE), T};
                pg8::gemm_phase(lds, gd, Sd, Ed);
            }
        }
        { pg8::moe_build_list<2>(UL, T, 2 * FFE / 256, G, bx, fast ? 1 : 0, tid, (const unsigned*)(ws + WS_ROWTOK), TOKL); pg8::ListOrder S; S.init(UL, T, 2 * FFE, D / 2, 1, (const unsigned*)(ws + WS_ROWTOK), TOKL); pg8::gemm_phase(lds, g, S, E); }
        if (BOTH(11)) GRID_BAR();
    }
    if (IN(12)) { PHASE_IDS;
        if (fast) {
            const int nrows = T[17] * 256; const unsigned* rowtok = (const unsigned*)(ws + WS_ROWTOK);
            for (int rr = gw; rr < nrows; rr += NGW) { const int k = rr >> 8, r = rr & 255, w = T[28 + k], e = w >> 8, idx = (w & 255) * 256 + r;
                if (idx < T[e]) { const unsigned tk = rowtok[(size_t)e * CAP + idx];
                    const u32x4* src = (const u32x4*)(ws + WS_Y2X + (size_t)rr * D); u32x4* dst = (u32x4*)(ws + ((tk >> 31) ? WS_Y2 : WS_Y1) + (size_t)(tk & 0x7fffffffu) * D);
                    dst[lane] = src[lane]; } }
        }
        pg8::Gemm g{(const bf16_t*)(ws + WS_HM), (const bf16_t*)(ws + WS_WDE), FFE / 2}; pg8::moe_build_list<4>(UL, T, D / 256, G, bx, fast ? 1 : 0, tid, nullptr, TOKL); pg8::ListOrder S; S.init(UL, T, D, FFE / 2, 0, nullptr, TOKL);
        pg8::EpiMoeDown E{(bf16_t*)(ws + WS_Y1), (bf16_t*)(ws + WS_Y2), (bf16_t*)(ws + WS_Y2X), (const unsigned*)(ws + WS_ROWTOK), (const float*)(ws + WS_ROWGATE), T};
        pg8::gemm_phase(lds, g, S, E);
        if (BOTH(12)) GRID_BAR();
    }
    if (IN(13)) { PHASE_IDS;
        const unsigned char* y1 = ws + WS_Y1; const unsigned char* y2 = ws + WS_Y2;
        for (size_t i = ((size_t)bx * (NWAVES * 64) + tid) * 8; i < (size_t)M * D; i += (size_t)G * (NWAVES * 64) * 8) {
            const u32x4 x = __builtin_nontemporal_load((const u32x4*)(XB + i)); const u32x2 p = *(const u32x2*)(y1 + i), q = *(const u32x2*)(y2 + i);
            const f32x2 p0 = __builtin_amdgcn_cvt_pk_f32_fp8((int)p.x, false), p1 = __builtin_amdgcn_cvt_pk_f32_fp8((int)p.x, true), p2 = __builtin_amdgcn_cvt_pk_f32_fp8((int)p.y, false), p3 = __builtin_amdgcn_cvt_pk_f32_fp8((int)p.y, true);
            const f32x2 q0 = __builtin_amdgcn_cvt_pk_f32_fp8((int)q.x, false), q1 = __builtin_amdgcn_cvt_pk_f32_fp8((int)q.x, true), q2 = __builtin_amdgcn_cvt_pk_f32_fp8((int)q.y, false), q3 = __builtin_amdgcn_cvt_pk_f32_fp8((int)q.y, true);
            constexpr float YI = 1.0f / Y8_SCALE;
            const f32x4 a = (f32x4){bf_lo(x.x) + (p0.x + q0.x) * YI, bf_hi(x.x) + (p0.y + q0.y) * YI, bf_lo(x.y) + (p1.x + q1.x) * YI, bf_hi(x.y) + (p1.y + q1.y) * YI};
            const f32x4 b = (f32x4){bf_lo(x.z) + (p2.x + q2.x) * YI, bf_hi(x.z) + (p2.y + q2.y) * YI, bf_lo(x.w) + (p3.x + q3.x) * YI, bf_hi(x.w) + (p3.y + q3.y) * YI};
            __builtin_nontemporal_store(a, (f32x4*)(P.out + i)); __builtin_nontemporal_store(b, (f32x4*)(P.out + i + 4)); }
    }
#undef IN
#undef BOTH
#undef GRID_BAR
}

extern "C" void kernel_launch(void* const* d_in, const int* in_sizes, int n_in, void* d_out, int out_size, void* d_ws, size_t ws_size, hipStream_t stream) {
    static int grid = 0;
    if (grid == 0) {
        if (n_in != 24 || in_sizes[0] != M * D || out_size != M * D || ws_size < WS_END) { fprintf(stderr, "kernel_launch: unexpected shapes (n_in %d, in0 %d, out %d, ws %zu < %zu); nothing launched\n", n_in, n_in > 0 ? in_sizes[0] : -1, out_size, ws_size, (size_t)WS_END); grid = -1; return; }
        int dev = 0, cus = 0, per_cu = 0;
        if (hipGetDevice(&dev) != hipSuccess || hipDeviceGetAttribute(&cus, hipDeviceAttributeMultiprocessorCount, dev) != hipSuccess) { fprintf(stderr, "kernel_launch: device query failed\n"); grid = -1; return; }
        if (hipFuncSetAttribute((const void*)fwd, hipFuncAttributeMaxDynamicSharedMemorySize, LDS_BYTES) != hipSuccess) { fprintf(stderr, "kernel_launch: hipFuncSetAttribute(%d B LDS) failed\n", LDS_BYTES); grid = -1; return; }
        if (hipOccupancyMaxActiveBlocksPerMultiprocessor(&per_cu, (const void*)fwd, NWAVES * 64, LDS_BYTES) != hipSuccess || per_cu < 1) { fprintf(stderr, "kernel_launch: occupancy query reports %d workgroups per CU\n", per_cu); }
        (void)hipGetLastError();
        grid = cus;
    }
    if (grid < 0) return;
    if (hipMemsetAsync((char*)d_ws + WS_CTL, 0, CTL_ZERO_BYTES, stream) != hipSuccess) { fprintf(stderr, "kernel_launch: memset failed\n"); return; }
    Args a{};
    for (int i = 0; i < 24; ++i) a.in[i] = (const float*)d_in[i];
    a.out = (float*)d_out; a.ws = (unsigned char*)d_ws;
    for (int li = 0; li < N_LAUNCHES; ++li) {
        a.ph_lo = (N_LAUNCHES == 1) ? 0 : li; a.ph_hi = (N_LAUNCHES == 1) ? N_PHASES : li + 1; a.li = li; a.pad = 0;
        hipLaunchKernelGGL(fwd, dim3(grid), dim3(NWAVES * 64), LDS_BYTES, stream, a);
        const hipError_t le = hipPeekAtLastError();
        if (le != hipSuccess) { fprintf(stderr, "kernel_launch: launch %d failed: %s\n", li, hipGetErrorName(le)); break; }
    }
}
```
